# Optimizing an MI355X kernel written in HIP

```python
import functools
import jax
import jax.numpy as jnp
from jax import lax
import numpy as np

D_MODEL = 1024
BATCH = 16
SEQ = 2048
DEPTH = 4

GRID_W = 64
CTX_LEN = 256
N_BRANCH = 4
MIX_W = 256
HEAD_DIM = 64
N_HEADS = MIX_W // HEAD_DIM
D_FF = 2816
N_MOD = 9
ALPHA = (2 * DEPTH) ** 0.25
BETA = (8 * DEPTH) ** -0.25
LN_EPS = 1e-5
GN_EPS = 1e-5
RWKV_GN_EPS = 64e-5
RWKV_W_LORA = 64
RWKV_A_LORA = 64
RWKV_G_LORA = 160
RET_CHUNK = 128
ROPE_BASE = 10000.0
S5_GROUP = 16
S5_GROUPS = MIX_W // S5_GROUP
S5_STATE = 64
HGRN_CHUNK = 16
RWKV_SPLITS = (MIX_W, MIX_W, MIX_W, RWKV_W_LORA, RWKV_A_LORA, RWKV_G_LORA)
RET_SPLITS = (MIX_W, MIX_W, MIX_W, MIX_W)
HGRN_SPLITS = (MIX_W, MIX_W, MIX_W, MIX_W, MIX_W)
MIXER_SPLITS = (sum(RWKV_SPLITS), sum(RET_SPLITS), MIX_W, sum(HGRN_SPLITS))
P_IN = sum(MIXER_SPLITS)

kernel_name = 'hybrid_rwkv7_retnet_s5_hgrn2_diffusion_block'


def split_cols(p, sizes):
    return jnp.split(p, [int(s) for s in np.cumsum(sizes)[:-1]], axis=-1)


def to_heads(t):
    return t.reshape(t.shape[:-1] + (N_HEADS, HEAD_DIM))


def flip_time(t):
    return jnp.flip(t, axis=1)


def layer_norm(x, g, b):
    xf = x.astype(jnp.float32)
    xc = xf - jnp.mean(xf, -1, keepdims=True)
    var = jnp.mean(xc * xc, -1, keepdims=True)
    return xc * lax.rsqrt(var + LN_EPS) * g + b


def head_norm(y, g, eps, center):
    yf = y.astype(jnp.float32)
    if center:
        yf = yf - jnp.mean(yf, -1, keepdims=True)
    yf = yf * lax.rsqrt(jnp.mean(yf * yf, -1, keepdims=True) + eps)
    return yf.reshape(yf.shape[:2] + (-1,)) * g


def modulate(x, shift, scale):
    return x * (1.0 + scale[:, None]) + shift[:, None]


def swiglu(h, w1, w3, w2):
    return (jax.nn.silu(h @ w1) * (h @ w3)) @ w2


def centred_shift(p):
    prev = jnp.pad(p[:, :-1], ((0, 0), (1, 0), (0, 0)))
    nxt = jnp.pad(p[:, 1:], ((0, 0), (0, 1), (0, 0)))
    return 0.5 * (prev + nxt)


def axial_rope(t, rows, cols):
    nf = HEAD_DIM // 4
    inv = ROPE_BASE ** (-jnp.arange(nf, dtype=jnp.float32) / nf)
    ang = jnp.concatenate([rows[:, None] * inv, cols[:, None] * inv], -1)[None, :, None, :]
    cos, sin = jnp.cos(ang), jnp.sin(ang)
    t1, t2 = t[..., :HEAD_DIM // 2], t[..., HEAD_DIM // 2:]
    return jnp.concatenate([t1 * cos - t2 * sin, t1 * sin + t2 * cos], -1)


def two_stream_scan(scan_fn, ins_c, ins_l, s0, reverse):
    if reverse:
        ins_c = [flip_time(t) for t in ins_c]
        ins_l = [flip_time(t) for t in ins_l]
    y_c, s_c = scan_fn(*ins_c, s0)
    y_l, _ = scan_fn(*ins_l, s_c)
    if reverse:
        y_c, y_l = jax.tree_util.tree_map(flip_time, (y_c, y_l))
    return y_c, y_l


def rwkv7_scan(r, w, k, v, kk, b, s0):
    def step(S, inp):
        r_t, w_t, k_t, v_t, kk_t, b_t = inp
        sa = jnp.einsum('bhvk,bhk->bhv', S, kk_t)
        S = S * w_t[:, :, None, :] - sa[..., None] * b_t[:, :, None, :] + v_t[..., None] * k_t[:, :, None, :]
        return S, jnp.einsum('bhvk,bhk->bhv', S, r_t)
    xs = tuple(jnp.moveaxis(t.astype(jnp.float32), 1, 0) for t in (r, w, k, v, kk, b))
    S, ys = lax.scan(step, s0, xs)
    return jnp.moveaxis(ys, 0, 1), S


def rwkv7_mixer(p_c, p_l, mu, w0, w2, a0, a2, g2, k_k, k_a, r_k, gn_g):
    def prep(p):
        p = p + mu * (centred_shift(p) - p)
        r, k, v, wd, ad, gd = split_cols(p, RWKV_SPLITS)
        kk = to_heads(k * k_k)
        kk = kk * lax.rsqrt(jnp.maximum(jnp.sum(kk * kk, -1, keepdims=True), 1e-12))
        dirs = []
        for d in range(2):
            logw = -jax.nn.softplus(-(w0[d] + jnp.tanh(wd) @ w2[d])) - 0.5
            a = to_heads(jax.nn.sigmoid(a0[d] + ad @ a2[d]))
            kd = to_heads(k) * (1.0 + (a - 1.0) * to_heads(k_a))
            dirs.append((to_heads(jnp.exp(-jnp.exp(logw))), kd, a))
        return to_heads(r), to_heads(v), kk, gd, dirs

    r_c, v_c, kk_c, gd_c, dirs_c = prep(p_c)
    r_l, v_l, kk_l, gd_l, dirs_l = prep(p_l)
    s0 = jnp.zeros((p_c.shape[0], N_HEADS, HEAD_DIM, HEAD_DIM), jnp.float32)
    rk = to_heads(r_k)
    y_c = y_l = bonus_c = bonus_l = 0.0
    for d in range(2):
        w_c, kd_c, a_c = dirs_c[d]
        w_l, kd_l, a_l = dirs_l[d]
        o_c, o_l = two_stream_scan(rwkv7_scan, (r_c, w_c, kd_c, v_c, kk_c, kk_c * a_c),
                                   (r_l, w_l, kd_l, v_l, kk_l, kk_l * a_l), s0, d == 1)
        y_c, y_l = y_c + o_c, y_l + o_l
        bonus_c = bonus_c + jnp.sum(r_c * kd_c * rk, -1, keepdims=True) * v_c
        bonus_l = bonus_l + jnp.sum(r_l * kd_l * rk, -1, keepdims=True) * v_l

    def out(y, bonus, gd):
        y = head_norm(y, gn_g, RWKV_GN_EPS, True) + bonus.reshape(bonus.shape[:2] + (MIX_W,))
        return y * (jax.nn.sigmoid(gd) @ g2)
    return out(y_c, bonus_c, gd_c), out(y_l, bonus_l, gd_l)


def retention_chunked(q, k, v, s0, log_gamma, include_diag):
    bsz, L, H, _ = q.shape
    n = L // RET_CHUNK
    qc, kc, vc = (t.astype(jnp.float32).reshape(bsz, n, RET_CHUNK, H, -1) for t in (q, k, v))
    idx = jnp.arange(RET_CHUNK, dtype=jnp.float32)
    dist = idx[:, None] - idx[None, :]
    mask = dist >= 0 if include_diag else dist > 0
    decay = jnp.where(mask, jnp.exp(log_gamma[:, None, None] * jnp.maximum(dist, 0.0)), 0.0)
    scores = jnp.einsum('bnthd,bnshd->bnhts', qc, kc) * decay
    o = jnp.einsum('bnhts,bnshv->bnthv', scores, vc)
    q_dec = jnp.exp(log_gamma[None, :] * (idx[:, None] + 1.0))
    k_dec = jnp.exp(log_gamma[None, :] * (RET_CHUNK - 1.0 - idx[:, None]))
    kv = jnp.einsum('bnshd,bnshv->nbhdv', kc * k_dec[:, :, None], vc)
    g_chunk = jnp.exp(log_gamma * RET_CHUNK)[:, None, None]

    def step(S, kv_n):
        return S * g_chunk + kv_n, S
    S_last, S_prev = lax.scan(step, s0.astype(jnp.float32), kv)
    o = o + jnp.einsum('bnthd,nbhdv->bnthv', qc * q_dec[:, :, None], S_prev)
    return o.reshape(bsz, L, H, -1), S_last


def retention_mixer(p_c, p_l, gn_g, rows, cols):
    log_gamma = jnp.log(1.0 - 2.0 ** (-5.0 - jnp.arange(N_HEADS, dtype=jnp.float32)))

    def prep(p, rotary):
        q, k, v, g = split_cols(p, RET_SPLITS)
        q, k, v = to_heads(q), to_heads(k) * HEAD_DIM ** -0.5, to_heads(v)
        if rotary:
            q, k = axial_rope(q, rows, cols), axial_rope(k, rows, cols)
        return (q, k, v), g

    ins_c, g_c = prep(p_c, False)
    ins_l, g_l = prep(p_l, True)
    s0 = jnp.zeros((p_c.shape[0], N_HEADS, HEAD_DIM, HEAD_DIM), jnp.float32)
    fwd = two_stream_scan(functools.partial(retention_chunked, log_gamma=log_gamma, include_diag=True),
                          ins_c, ins_l, s0, False)
    bwd = two_stream_scan(functools.partial(retention_chunked, log_gamma=log_gamma, include_diag=False),
                          ins_c, ins_l, s0, True)

    def out(o, g):
        return head_norm(o, gn_g, GN_EPS, True) * jax.nn.silu(g)
    return out(fwd[0] + bwd[0], g_c), out(fwd[1] + bwd[1], g_l)


def s5_scan(lb_re, lb_im, bu_re, bu_im, s0):
    s0_re, s0_im = s0
    bu_re = bu_re.at[:, 0].add(lb_re * s0_re - lb_im * s0_im)
    bu_im = bu_im.at[:, 0].add(lb_re * s0_im + lb_im * s0_re)
    a_re = jnp.broadcast_to(lb_re, bu_re.shape)
    a_im = jnp.broadcast_to(lb_im, bu_im.shape)

    def combine(e1, e2):
        a1r, a1i, b1r, b1i = e1
        a2r, a2i, b2r, b2i = e2
        return (a1r * a2r - a1i * a2i, a1r * a2i + a1i * a2r,
                a2r * b1r - a2i * b1i + b2r, a2r * b1i + a2i * b1r + b2i)
    _, _, s_re, s_im = lax.associative_scan(combine, (a_re, a_im, bu_re, bu_im), axis=1)
    return (s_re, s_im), (s_re[:, -1], s_im[:, -1])


def s5_mixer(u_c, u_l, lam_re, lam_im, log_dt, b_re, b_im, c_re, c_im, d_skip, w_glu, b_glu):
    u_c, u_l = u_c.astype(jnp.float32), u_l.astype(jnp.float32)
    bsz = u_c.shape[0]
    y_c, y_l = d_skip * u_c, d_skip * u_l
    s0 = (jnp.zeros((bsz, S5_GROUPS, S5_STATE), jnp.float32),) * 2
    for d in range(2):
        lr, li = lam_re[d], lam_im[d]
        dt = jnp.exp(log_dt[d])[:, None]
        mag = jnp.exp(lr * dt)
        lb_re, lb_im = mag * jnp.cos(li * dt), mag * jnp.sin(li * dt)
        den = lr * lr + li * li
        f_re = ((lb_re - 1.0) * lr + lb_im * li) / den
        f_im = (lb_im * lr - (lb_re - 1.0) * li) / den
        bb_re = f_re[..., None] * b_re[d] - f_im[..., None] * b_im[d]
        bb_im = f_re[..., None] * b_im[d] + f_im[..., None] * b_re[d]

        def drive(u):
            ug = u.reshape(u.shape[:2] + (S5_GROUPS, S5_GROUP))
            return (jnp.einsum('gpi,blgi->blgp', bb_re, ug), jnp.einsum('gpi,blgi->blgp', bb_im, ug))

        st_c, st_l = two_stream_scan(functools.partial(s5_scan, lb_re, lb_im),
                                     drive(u_c), drive(u_l), s0, d == 1)

        def read(st):
            s_re, s_im = st
            y = jnp.einsum('gop,blgp->blgo', c_re[d], s_re) - jnp.einsum('gop,blgp->blgo', c_im[d], s_im)
            return y.reshape(y.shape[:2] + (MIX_W,))
        y_c = y_c + read(st_c)
        y_l = y_l + read(st_l)

    def glu(y):
        y = jax.nn.gelu(y)
        return y * jax.nn.sigmoid(y @ w_glu + b_glu)
    return glu(y_c), glu(y_l)


def gated_chunked(q, k, v, logf, s0):
    bsz, L, H, _ = q.shape
    n = L // HGRN_CHUNK
    qc, kc, vc, lf = (t.astype(jnp.float32).reshape(bsz, n, HGRN_CHUNK, H, -1) for t in (q, k, v, logf))
    b = jnp.cumsum(lf, axis=2)
    idx = jnp.arange(HGRN_CHUNK)
    mask = (idx[:, None] >= idx[None, :])[None, None, :, :, None, None]
    rel = b[:, :, :, None] - b[:, :, None, :]
    dec = jnp.where(mask, jnp.exp(jnp.minimum(rel, 0.0)), 0.0)
    scores = jnp.einsum('bnthd,bnshd,bntshd->bnhts', qc, kc, dec)
    o = jnp.einsum('bnhts,bnshv->bnthv', scores, vc)
    b_last = b[:, :, -1]
    kv = jnp.einsum('bnshd,bnshv->nbhdv', kc * jnp.exp(b_last[:, :, None] - b), vc)

    def step(S, inp):
        g_n, kv_n = inp
        return S * g_n[..., None] + kv_n, S
    S_last, S_prev = lax.scan(step, s0.astype(jnp.float32), (jnp.moveaxis(jnp.exp(b_last), 1, 0), kv))
    o = o + jnp.einsum('bnthd,nbhdv->bnthv', qc * jnp.exp(b), S_prev)
    return o.reshape(bsz, L, H, -1), S_last


def hgrn2_mixer(p_c, p_l, lb, f_bias, gn_g):
    def prep(p):
        q, zf, zb, i, g = split_cols(p, HGRN_SPLITS)
        dirs = []
        for d, z in enumerate((zf, zb)):
            f = lb + (1.0 - lb) * jax.nn.sigmoid((z + f_bias[d]).astype(jnp.float32))
            dirs.append((to_heads(1.0 - f), to_heads(jnp.log(f))))
        return to_heads(q), to_heads(i), g, dirs

    q_c, i_c, g_c, dirs_c = prep(p_c)
    q_l, i_l, g_l, dirs_l = prep(p_l)
    s0 = jnp.zeros((p_c.shape[0], N_HEADS, HEAD_DIM, HEAD_DIM), jnp.float32)
    o_c = o_l = 0.0
    for d in range(2):
        (k_c, lf_c), (k_l, lf_l) = dirs_c[d], dirs_l[d]
        y_c, y_l = two_stream_scan(gated_chunked, (q_c, k_c, i_c, lf_c), (q_l, k_l, i_l, lf_l), s0, d == 1)
        o_c, o_l = o_c + y_c, o_l + y_l

    def out(o, g):
        return head_norm(o, gn_g, GN_EPS, False) * jax.nn.silu(g)
    return out(o_c, g_c), out(o_l, g_l)


def gated_merge(h, ys, w_branch, w_gate, b_gate, w_out):
    bsz, L, _ = h.shape
    gates = jax.nn.sigmoid(h @ w_gate + b_gate).reshape(bsz, L, N_BRANCH, D_MODEL)
    branches = jnp.einsum('blnw,nwd->blnd', jnp.stack(ys, axis=2), w_branch)
    return jnp.einsum('blnd,blnd->bld', gates, branches) @ w_out


def setup_inputs(seed: int = 0) -> dict:
    key = jax.random.key(seed)
    ks = iter(jax.random.split(key, 48))

    def nrm(shape, scale=1.0):
        return scale * jax.random.normal(next(ks), shape, jnp.float32)

    def uni(shape, lo, hi):
        return jax.random.uniform(next(ks), shape, jnp.float32, lo, hi)

    Ld, G, P, W = DEPTH, S5_GROUPS, S5_STATE, MIX_W
    return {
        'x': nrm((BATCH, SEQ, D_MODEL)),
        'c': nrm((BATCH, D_MODEL)),
        'ctx': nrm((BATCH, CTX_LEN, D_MODEL)),
        'c_ctx': nrm((D_MODEL,)),
        'w_ada': nrm((Ld, D_MODEL, N_MOD * D_MODEL), D_MODEL ** -0.5),
        'b_ada': nrm((Ld, N_MOD * D_MODEL), 0.02),
        'ln_g': 1.0 + nrm((Ld, 3, D_MODEL), 0.02),
        'ln_b': nrm((Ld, 3, D_MODEL), 0.02),
        'ffn_w1': nrm((Ld, 2, D_MODEL, D_FF), D_MODEL ** -0.5),
        'ffn_w3': nrm((Ld, 2, D_MODEL, D_FF), D_MODEL ** -0.5),
        'ffn_w2': nrm((Ld, 2, D_FF, D_MODEL), BETA * D_FF ** -0.5),
        'w_in': nrm((Ld, D_MODEL, P_IN), D_MODEL ** -0.5),
        'rwkv_mu': uni((Ld, MIXER_SPLITS[0]), 0.0, 1.0),
        'rwkv_w0': uni((Ld, 2, W), -6.0, -1.0),
        'rwkv_w2': nrm((Ld, 2, RWKV_W_LORA, W), 0.1),
        'rwkv_a0': nrm((Ld, 2, W), 0.1),
        'rwkv_a2': nrm((Ld, 2, RWKV_A_LORA, W), 0.5 * RWKV_A_LORA ** -0.5),
        'rwkv_g2': nrm((Ld, RWKV_G_LORA, W), RWKV_G_LORA ** -0.5),
        'rwkv_kk': 0.85 + nrm((Ld, W), 0.02),
        'rwkv_ka': 1.0 + nrm((Ld, W), 0.02),
        'rwkv_rk': nrm((Ld, W), 0.1),
        'rwkv_gn': 1.0 + nrm((Ld, W), 0.02),
        'ret_gn': 1.0 + nrm((Ld, W), 0.02),
        's5_lam_re': -0.5 + nrm((Ld, 2, G, P), 0.01),
        's5_lam_im': jnp.pi * jnp.arange(P, dtype=jnp.float32) + nrm((Ld, 2, G, P), 0.01),
        's5_log_dt': uni((Ld, 2, G), float(np.log(0.001)), float(np.log(0.1))),
        's5_b_re': nrm((Ld, 2, G, P, S5_GROUP), (2.0 * S5_GROUP) ** -0.5),
        's5_b_im': nrm((Ld, 2, G, P, S5_GROUP), (2.0 * S5_GROUP) ** -0.5),
        's5_c_re': nrm((Ld, 2, G, S5_GROUP, P), (2.0 * P) ** -0.5),
        's5_c_im': nrm((Ld, 2, G, S5_GROUP, P), (2.0 * P) ** -0.5),
        's5_d': nrm((Ld, W)),
        's5_w_glu': nrm((Ld, W, W), W ** -0.5),
        's5_b_glu': nrm((Ld, W), 0.02),
        'hgrn_lb_logits': nrm((Ld, W)),
        'hgrn_f_bias': nrm((Ld, 2, W), 0.1),
        'hgrn_gn': 1.0 + nrm((Ld, W), 0.02),
        'w_branch': nrm((Ld, N_BRANCH, W, D_MODEL), BETA * W ** -0.5),
        'w_gate': nrm((Ld, D_MODEL, N_BRANCH * D_MODEL), D_MODEL ** -0.5),
        'b_gate': nrm((Ld, N_BRANCH * D_MODEL), 0.02),
        'w_out': nrm((Ld, D_MODEL, D_MODEL), BETA * D_MODEL ** -0.5),
    }


def reference(x, c, ctx, c_ctx, w_ada, b_ada, ln_g, ln_b, ffn_w1, ffn_w3, ffn_w2, w_in,
              rwkv_mu, rwkv_w0, rwkv_w2, rwkv_a0, rwkv_a2, rwkv_g2, rwkv_kk, rwkv_ka, rwkv_rk, rwkv_gn,
              ret_gn, s5_lam_re, s5_lam_im, s5_log_dt, s5_b_re, s5_b_im, s5_c_re, s5_c_im, s5_d,
              s5_w_glu, s5_b_glu, hgrn_lb_logits, hgrn_f_bias, hgrn_gn, w_branch, w_gate, b_gate, w_out):
    L = x.shape[1]
    rows_n = L // GRID_W
    rows = jnp.repeat(jnp.arange(rows_n, dtype=jnp.float32), GRID_W)
    cols = jnp.tile(jnp.arange(GRID_W, dtype=jnp.float32), rows_n)
    lb_soft = jax.nn.softmax(hgrn_lb_logits.astype(jnp.float32), axis=0)
    lower_bounds = jnp.cumsum(lb_soft, axis=0) - lb_soft[0]

    for l in range(DEPTH):
        last = l == DEPTH - 1
        m_l = jnp.split(jax.nn.silu(c) @ w_ada[l] + b_ada[l], N_MOD, axis=-1)
        m_c = jnp.split(jax.nn.silu(c_ctx)[None] @ w_ada[l] + b_ada[l], N_MOD, axis=-1)

        def ffn_sublayer(s, m, j):
            h = modulate(s, m[3 * j], m[3 * j + 1])
            upd = 0.5 * m[3 * j + 2][:, None] * swiglu(h, ffn_w1[l, j // 2], ffn_w3[l, j // 2], ffn_w2[l, j // 2])
            return layer_norm(ALPHA * s + upd, ln_g[l, j], ln_b[l, j])

        x = ffn_sublayer(x, m_l, 0)
        ctx = ffn_sublayer(ctx, m_c, 0)

        h_l = modulate(x, m_l[3], m_l[4])
        h_c = modulate(ctx, m_c[3], m_c[4])
        pa_c, pb_c, pc_c, pd_c = split_cols(h_c @ w_in[l], MIXER_SPLITS)
        pa_l, pb_l, pc_l, pd_l = split_cols(h_l @ w_in[l], MIXER_SPLITS)
        ya_c, ya_l = rwkv7_mixer(pa_c, pa_l, rwkv_mu[l], rwkv_w0[l], rwkv_w2[l], rwkv_a0[l], rwkv_a2[l],
                                 rwkv_g2[l], rwkv_kk[l], rwkv_ka[l], rwkv_rk[l], rwkv_gn[l])
        yb_c, yb_l = retention_mixer(pb_c, pb_l, ret_gn[l], rows, cols)
        yc_c, yc_l = s5_mixer(pc_c, pc_l, s5_lam_re[l], s5_lam_im[l], s5_log_dt[l], s5_b_re[l], s5_b_im[l],
                              s5_c_re[l], s5_c_im[l], s5_d[l], s5_w_glu[l], s5_b_glu[l])
        yd_c, yd_l = hgrn2_mixer(pd_c, pd_l, lower_bounds[l], hgrn_f_bias[l], hgrn_gn[l])

        mix_l = gated_merge(h_l, (ya_l, yb_l, yc_l, yd_l), w_branch[l], w_gate[l], b_gate[l], w_out[l])
        x = layer_norm(ALPHA * x + m_l[5][:, None] * mix_l, ln_g[l, 1], ln_b[l, 1])
        x = ffn_sublayer(x, m_l, 2)

        if not last:
            mix_c = gated_merge(h_c, (ya_c, yb_c, yc_c, yd_c), w_branch[l], w_gate[l], b_gate[l], w_out[l])
            ctx = layer_norm(ALPHA * ctx + m_c[5][:, None] * mix_c, ln_g[l, 1], ln_b[l, 1])
            ctx = ffn_sublayer(ctx, m_c, 2)
    return x
```

```cpp
#include <hip/hip_runtime.h>
#include <hip/hip_cooperative_groups.h>
#include <cstdio>
#include <cstdint>
namespace cg = cooperative_groups;

typedef unsigned short bf16_t;
using bf16x8 = __attribute__((ext_vector_type(8))) short;
using f32x4 = __attribute__((ext_vector_type(4))) float;

#define DEVINL __device__ __forceinline__

constexpr int NB = 16, SEQT = 2304, MROWS = NB * SEQT;
constexpr int D = 1024, FF = 2816, DEPTH = 4;
constexpr int PRW = 1056, PREST = 2560;
constexpr float ALPHA = 1.681792830507429f;
constexpr int LDS_BYTES = 131072 + 256;

constexpr size_t OFF_X = 0;
constexpr size_t OFF_MOD = OFF_X + (size_t)MROWS * 1024 * 4;
constexpr size_t OFF_TAB = OFF_MOD + (size_t)4 * 17 * 9216 * 4;
constexpr size_t OFF_W13 = OFF_TAB + 12288;
constexpr size_t OFF_W2 = OFF_W13 + (size_t)5632 * 1024 * 2;
constexpr size_t OFF_WIN = OFF_W2 + (size_t)1024 * 2816 * 2;
constexpr size_t OFF_WG = OFF_WIN + (size_t)3840 * 1024 * 2;
constexpr size_t OFF_WB = OFF_WG + (size_t)4096 * 1024 * 2;
constexpr size_t OFF_WO4 = OFF_WB + (size_t)4096 * 256 * 2;
constexpr size_t OFF_WL = OFF_WO4 + (size_t)1024 * 4096 * 2;
constexpr size_t OFF_WGLU = OFF_WL + (size_t)1280 * 384 * 2;
constexpr size_t OFF_BAR = OFF_WGLU + (size_t)256 * 256 * 2;
constexpr size_t OFF_AR = OFF_BAR + 16384;
constexpr size_t AR_PREST = 0;
constexpr size_t AR_L = AR_PREST + (size_t)MROWS * PREST * 2;
constexpr size_t AR_RKV = AR_L + (size_t)MROWS * 1280 * 2;
constexpr size_t AR_OUT = AR_RKV + (size_t)MROWS * 1024 * 2;
constexpr size_t AR_END = AR_OUT + (size_t)9 * MROWS * 256 * 2;
constexpr size_t AR_PRW = AR_OUT;
constexpr size_t AR_A2 = AR_OUT + (size_t)MROWS * PRW * 2;
constexpr size_t AR_HFFN = 0;
constexpr size_t AR_U = (size_t)MROWS * 1024 * 2;
constexpr size_t AR_HMIX = AR_L;
constexpr size_t AR_BR = 0;
constexpr size_t AR_MODP = 0;
constexpr size_t WS_NEED = OFF_AR + AR_END;
constexpr size_t OUTSLOT = (size_t)MROWS * 256;
constexpr size_t AR_HP = AR_OUT + 4 * OUTSLOT * 2;
static_assert((size_t)MROWS * 4096 * 2 <= AR_OUT, "Br must not reach the OUT slots");

struct Params {
  const float* in[40];
  float* out;
  char* ws;
  unsigned long long ws_size;
  int wave;
  int pad_;
};

DEVINL int otid(int wave) { int ln; asm volatile("v_mbcnt_lo_u32_b32 %0, -1, 0\n\tv_mbcnt_hi_u32_b32 %0, -1, %0" : "=v"(ln)); return wave * 64 + ln; }
DEVINL bf16_t f2bf(float f) {
  unsigned u = __float_as_uint(f);
  u += 0x7fffu + ((u >> 16) & 1u);
  return (bf16_t)(u >> 16);
}
DEVINL float bf2f(bf16_t h) { return __uint_as_float(((unsigned)h) << 16); }
typedef __bf16 bf16x2_t __attribute__((ext_vector_type(2)));
DEVINL unsigned pk2(float a, float b) { bf16x2_t v = {(__bf16)a, (__bf16)b}; return __builtin_bit_cast(unsigned, v); }
DEVINL float sigm(float x) { return __builtin_amdgcn_rcpf(1.f + __expf(-x)); }
DEVINL float silu(float x) { return x * __builtin_amdgcn_rcpf(1.f + __expf(-x)); }
DEVINL float tanh_fast(float x) { return 1.f - 2.f * __builtin_amdgcn_rcpf(1.f + __expf(2.f * x)); }
DEVINL float wave_sum(float v) {
#pragma unroll
  for (int o = 32; o > 0; o >>= 1) v += __shfl_xor(v, o);
  return v;
}

DEVINL void conv_tile(int wave, bool valid, const float* __restrict__ src, int ldsrc, int k0, int kval, int n0, int nval,
                      bf16_t* dst, int ldd, int dk0, int mode, int which, int drow0, float* sm) {
  const int tid = otid(wave) & 255;
#pragma unroll
  for (int i = 0; i < 16; ++i) {
    int k = i * 4 + (tid >> 6), n = tid & 63;
    float v = 0.f;
    if (valid && src != nullptr && (k0 + k) < kval && (n0 + n) < nval) v = src[(size_t)(k0 + k) * ldsrc + n0 + n];
    sm[k * 65 + n] = v;
  }
  __syncthreads();
  if (valid) {
#pragma unroll
    for (int i = 0; i < 8; ++i) {
      int j = i * 8 + (tid >> 5), kp = tid & 31;
      int n = n0 + j;
      int drow = (mode == 1) ? ((n >> 4) * 32 + which * 16 + (n & 15)) : (drow0 + j);
      unsigned lo = f2bf(sm[(2 * kp) * 65 + j]), hi = f2bf(sm[(2 * kp + 1) * 65 + j]);
      *(unsigned*)(dst + (size_t)drow * ldd + dk0 + 2 * kp) = lo | (hi << 16);
    }
  }
  __syncthreads();
}

DEVINL void conv_ffn(const Params& p, int l, int i, float* smf, int t_lo = 0, int t_hi = 2112, int blk0 = 0) {
  char* ws = p.ws;
  bf16_t* W13 = (bf16_t*)(ws + OFF_W13);
  bf16_t* W2 = (bf16_t*)(ws + OFF_W2);
  const float* w1 = p.in[8] + (size_t)(l * 2 + i) * 1024 * 2816;
  const float* w3 = p.in[9] + (size_t)(l * 2 + i) * 1024 * 2816;
  const float* w2 = p.in[10] + (size_t)(l * 2 + i) * 2816 * 1024;
  const int half = otid(p.wave) >> 8;
  float* sm = smf + half * 4160;
  if ((int)blockIdx.x < blk0) return;
  for (int t0 = t_lo + ((int)blockIdx.x - blk0) * 2; t0 < t_hi; t0 += ((int)gridDim.x - blk0) * 2) {
    int t = t0 + half; bool valid = t < t_hi; if (!valid) t = t_hi - 1;
    if (t < 1408) {
      int which = t >= 704; int tt = t - which * 704;
      int nt_ = tt % 44, kt = tt / 44;
      conv_tile(p.wave, valid, which ? w3 : w1, 2816, kt * 64, 1024, nt_ * 64, 2816, W13, 1024, kt * 64, 1, which, 0, sm);
    } else {
      int tt = t - 1408; int nt_ = tt % 16, kt = tt / 16;
      conv_tile(p.wave, valid, w2, 1024, kt * 64, 2816, nt_ * 64, 1024, W2, 2816, kt * 64, 0, 0, nt_ * 64, sm);
    }
  }
}

DEVINL void conv_mix(const Params& p, int l, float* smf, int blk0 = 0) {
  char* ws = p.ws;
  const int half = otid(p.wave) >> 8;
  float* sm = smf + half * 4160;
  const int T = 3400;
  if ((int)blockIdx.x < blk0) return;
  for (int t0 = ((int)blockIdx.x - blk0) * 2; t0 < T; t0 += ((int)gridDim.x - blk0) * 2) {
    int t = t0 + half; bool valid = t < T; if (!valid) t = T - 1;
    if (t < 960) {
      int nt_ = t % 60, kt = t / 60;
      conv_tile(p.wave, valid, p.in[11] + (size_t)l * 1024 * 3616, 3616, kt * 64, 1024, nt_ * 64, 3616,
                (bf16_t*)(ws + OFF_WIN), 1024, kt * 64, 0, 0, nt_ * 64, sm);
    } else if (t < 1984) {
      int tt = t - 960; int nt_ = tt % 64, kt = tt / 64;
      conv_tile(p.wave, valid, p.in[37] + (size_t)l * 1024 * 4096, 4096, kt * 64, 1024, nt_ * 64, 4096,
                (bf16_t*)(ws + OFF_WG), 1024, kt * 64, 0, 0, nt_ * 64, sm);
    } else if (t < 2240) {
      int tt = t - 1984; int n = tt >> 6; int r = tt & 63; int nt_ = r % 16, kt = r / 16;
      conv_tile(p.wave, valid, p.in[36] + (size_t)(l * 4 + n) * 256 * 1024, 1024, kt * 64, 256, nt_ * 64, 1024,
                (bf16_t*)(ws + OFF_WB) + (size_t)n * 1024 * 256, 256, kt * 64, 0, 0, nt_ * 64, sm);
    } else if (t < 3264) {
      int tt = t - 2240; int rep = tt >> 8; int r = tt & 255; int nt_ = r % 16, kt = r / 16;
      conv_tile(p.wave, valid, p.in[39] + (size_t)l * 1024 * 1024, 1024, kt * 64, 1024, nt_ * 64, 1024,
                (bf16_t*)(ws + OFF_WO4), 4096, rep * 1024 + kt * 64, 0, 0, nt_ * 64, sm);
    } else if (t < 3280) {
      int tt = t - 3264; int nt_ = tt % 4, kt = tt / 4;
      conv_tile(p.wave, valid, p.in[31] + (size_t)l * 256 * 256, 256, kt * 64, 256, nt_ * 64, 256,
                (bf16_t*)(ws + OFF_WGLU), 256, kt * 64, 0, 0, nt_ * 64, sm);
    } else {
      int tt = t - 3280; int nt_ = tt % 20, kt = tt / 20;
      int seg = nt_ >> 2, sub = nt_ & 3;
      const float* s_ = nullptr; int k0 = 0, kval = 0;
      if (seg == 0 && kt == 0) { s_ = p.in[14] + (size_t)(l * 2 + 0) * 64 * 256; kval = 64; }
      else if (seg == 1 && kt == 0) { s_ = p.in[14] + (size_t)(l * 2 + 1) * 64 * 256; kval = 64; }
      else if (seg == 2 && kt == 1) { s_ = p.in[16] + (size_t)(l * 2 + 0) * 64 * 256; kval = 64; }
      else if (seg == 3 && kt == 1) { s_ = p.in[16] + (size_t)(l * 2 + 1) * 64 * 256; kval = 64; }
      else if (seg == 4 && kt >= 2 && kt <= 4) { s_ = p.in[17] + (size_t)l * 160 * 256; k0 = (kt - 2) * 64; kval = 160; }
      conv_tile(p.wave, valid, s_, 256, k0, kval, sub * 64, 256, (bf16_t*)(ws + OFF_WL), 384, kt * 64, 0, 0, nt_ * 64, sm);
    }
  }
}

namespace pg8 {
#define PG8_LAS __attribute__((address_space(3)))
constexpr int BM = 256, BK = 64, HALF = 128, HTB = HALF * BK * 2, STAGE_BYTES = 8 * HTB, NXCD = 8, WGM = 4;
DEVINL int lds_byte(int r, int c) { const int st = (r >> 4) * 2 + (c >> 5), rr = r & 15, cc = c & 31, ob = rr * 64 + cc * 2; return st * 1024 + (ob ^ (((ob >> 9) & 1) << 5)); }
DEVINL void stage_rc(int b, int& R, int& C) { const int st = b / 1024, sb = b % 1024, swz = sb ^ (((sb >> 9) & 1) << 5); R = (st >> 1) * 16 + swz / 64; C = (st & 1) * 32 + (swz % 64) / 2; }
struct Unit { int pm, pn; };
struct Gemm { const bf16_t* A; const bf16_t* Bt; int M, N, K; };
struct StaticOrder {
    int nM, nN, nwg, G, c, skip;
    DEVINL void init(int M, int N, int G_, int c_, int skip_) { nM = M / BM; if (skip_) nM = (nM / 9) * 8; nN = N / BM; nwg = nM * nN; G = G_; c = c_; skip = skip_; }
    DEVINL bool next(int i, Unit& u) const {
        const long Lx = (long)i * G + c; if (Lx >= nwg) return false;
        int wgid = (int)Lx; { const int q = nwg / NXCD, r = nwg % NXCD, xcd = wgid % NXCD, off = wgid / NXCD; wgid = (xcd < r ? xcd * (q + 1) : r * (q + 1) + (xcd - r) * q) + off; }
        const int nig = WGM * nN, gid = wgid / nig, fm = gid * WGM, gsz = (nM - fm) < WGM ? (nM - fm) : WGM;
        u.pm = fm + ((wgid % nig) % gsz); u.pn = (wgid % nig) / gsz;
        if (skip) u.pm = (u.pm >> 3) * 9 + 1 + (u.pm & 7);
        return true;
    }
    DEVINL void a_ready(const Unit&) const {}
    DEVINL void done(const Unit&) const {}
};
struct BranchOrder : StaticOrder {
    DEVINL bool next(int i, Unit& u) const { if (!StaticOrder::next(i, u)) return false; u.pn = (u.pm / 144) * 4 + u.pn; return true; }
};
struct GateOrder : BranchOrder {
    DEVINL bool next(int i, Unit& u) const { if (!BranchOrder::next(i, u)) return false; u.pm = u.pm % 144; return true; }
};

template <class Epi, class Sched>
DEVINL void gemm_phase(int wave, PG8_LAS unsigned char* lds, const Gemm g, const Sched& S, const Epi& E) {
    const int tid = otid(wave), wid = __builtin_amdgcn_readfirstlane(tid >> 6), lane = tid & 63, wr = wid >> 2, wc = wid & 3, fr = lane & 15, fq = lane >> 4;
    const int K = g.K, nt = K / BK;
    unsigned voffA[2], voffB[2];
#pragma unroll
    for (int i = 0; i < 2; ++i) { int R, C; stage_rc(tid * 16 + i * 8192, R, C);
        voffA[i] = (unsigned)(R * K + C) * 2u; voffB[i] = (unsigned)(R * K + C) * 2u; }
    const size_t kstep = (size_t)(BK * 2);
    const size_t hstep = (size_t)HALF * K * 2;
    const size_t tstep = 2 * hstep;
    const unsigned ldsw = (unsigned)wid * 1024u;
    const int aoff = lds_byte(wr * 64 + fr, fq * 8), boff = lds_byte(wc * 32 + fr, fq * 8);
#define PG8_SA(b, h) (((b) * 2 + (h)) * HTB)
#define PG8_SB(b, h) ((4 + (b) * 2 + (h)) * HTB)
#define PG8_STAGE(bufoff, gbase, voff) do { _Pragma("unroll") for (int _i = 0; _i < 2; ++_i) \
        __builtin_amdgcn_global_load_lds((const unsigned*)((const char*)(gbase) + (voff)[_i]), (PG8_LAS unsigned*)(lds + (bufoff) + ldsw + _i * 8192), 16, 0, 0); } while (0)
#define PG8_LDA(dst, b, h) do { _Pragma("unroll") for (int m = 0; m < 4; ++m) _Pragma("unroll") for (int k = 0; k < 2; ++k) dst[m][k] = *(const PG8_LAS bf16x8*)(lds + PG8_SA(b, h) + aoff + m * 2048 + k * 1024); } while (0)
#define PG8_LDB(dst, b, h) do { _Pragma("unroll") for (int n = 0; n < 2; ++n) _Pragma("unroll") for (int k = 0; k < 2; ++k) dst[n][k] = *(const PG8_LAS bf16x8*)(lds + PG8_SB(b, h) + boff + n * 2048 + k * 1024); } while (0)
#define PG8_MMA(ai, bj, At, Bt) do { __builtin_amdgcn_s_setprio(1); _Pragma("unroll") for (int m = 0; m < 4; ++m) _Pragma("unroll") for (int n = 0; n < 2; ++n) _Pragma("unroll") for (int k = 0; k < 2; ++k) \
        acc[ai][bj][m][n] = __builtin_amdgcn_mfma_f32_16x16x32_bf16(Bt[n][k], At[m][k], acc[ai][bj][m][n], 0, 0, 0); __builtin_amdgcn_s_setprio(0); } while (0)
#define PG8_WAIT_V(n) asm volatile("s_waitcnt vmcnt(" #n ")" ::: "memory")
#define PG8_WAIT_L(n) asm volatile("s_waitcnt lgkmcnt(" #n ")" ::: "memory")
#define PG8_BAR __builtin_amdgcn_s_barrier()
#define PG8_SCHED __builtin_amdgcn_sched_barrier(0)
    Unit cur, nxt; int ui = 0;
    if (!S.next(0, cur)) return;
    f32x4 acc[2][2][4][2];
#pragma unroll
    for (int a = 0; a < 2; ++a)
#pragma unroll
        for (int b = 0; b < 2; ++b)
#pragma unroll
            for (int m = 0; m < 4; ++m)
#pragma unroll
                for (int n = 0; n < 2; ++n) acc[a][b][m][n] = (f32x4){0.f, 0.f, 0.f, 0.f};
    bf16x8 At[4][2], B0[2][2], B1[2][2];
    const char* cA = (const char*)g.A + (size_t)cur.pm * tstep; const char* cB = (const char*)g.Bt + (size_t)cur.pn * tstep;
    S.a_ready(cur);
    PG8_STAGE(PG8_SB(0, 0), cB, voffB); PG8_STAGE(PG8_SA(0, 0), cA, voffA); PG8_STAGE(PG8_SB(0, 1), cB + hstep, voffB); PG8_STAGE(PG8_SA(0, 1), cA + hstep, voffA);
    if (wr == 1) PG8_BAR;
    PG8_WAIT_V(4); PG8_BAR;
    PG8_STAGE(PG8_SB(1, 0), cB + kstep, voffB); PG8_STAGE(PG8_SA(1, 0), cA + kstep, voffA); PG8_STAGE(PG8_SB(1, 1), cB + hstep + kstep, voffB);
    PG8_WAIT_V(6); PG8_BAR;
    for (;;) {
        const bool has_next = S.next(ui + 1, nxt);
        const char* nA = has_next ? (const char*)g.A + (size_t)nxt.pm * tstep : cA; const char* nB = has_next ? (const char*)g.Bt + (size_t)nxt.pn * tstep : cB;
        for (int t = 0; t < nt; t += 2) {
            const bool last = (t == nt - 2);
            const char* a1 = cA + (size_t)(t + 1) * kstep;
            const char* a2 = last ? nA : cA + (size_t)(t + 2) * kstep; const char* b2 = last ? nB : cB + (size_t)(t + 2) * kstep;
            const char* a3 = a2 + kstep; const char* b3 = b2 + kstep;
            if (last && has_next) S.a_ready(nxt);
            PG8_LDB(B0, 0, 0); PG8_SCHED; PG8_LDA(At, 0, 0); PG8_STAGE(PG8_SA(1, 1), a1 + hstep, voffA);
            PG8_WAIT_L(8); PG8_BAR; PG8_WAIT_L(0); PG8_MMA(0, 0, At, B0); PG8_BAR; PG8_SCHED;
            PG8_LDB(B1, 0, 1); PG8_STAGE(PG8_SB(0, 0), b2, voffB);
            PG8_BAR; PG8_WAIT_L(0); PG8_MMA(0, 1, At, B1); PG8_BAR;
            PG8_LDA(At, 0, 1); PG8_STAGE(PG8_SA(0, 0), a2, voffA);
            PG8_BAR; PG8_WAIT_L(0); PG8_MMA(1, 0, At, B0); PG8_BAR; PG8_SCHED;
            PG8_STAGE(PG8_SB(0, 1), b2 + hstep, voffB);
            PG8_WAIT_V(6); PG8_BAR; PG8_MMA(1, 1, At, B1); PG8_BAR;
            PG8_LDB(B0, 1, 0); PG8_SCHED; PG8_LDA(At, 1, 0); PG8_STAGE(PG8_SA(0, 1), a2 + hstep, voffA);
            PG8_WAIT_L(8); PG8_BAR; PG8_WAIT_L(0); PG8_MMA(0, 0, At, B0); PG8_BAR; PG8_SCHED;
            PG8_LDB(B1, 1, 1); PG8_STAGE(PG8_SB(1, 0), b3, voffB);
            PG8_BAR; PG8_WAIT_L(0); PG8_MMA(0, 1, At, B1); PG8_BAR;
            PG8_LDA(At, 1, 1); PG8_STAGE(PG8_SA(1, 0), a3, voffA);
            PG8_BAR; PG8_WAIT_L(0); PG8_MMA(1, 0, At, B0); PG8_BAR; PG8_SCHED;
            PG8_STAGE(PG8_SB(1, 1), b3 + hstep, voffB);
            PG8_WAIT_V(6); PG8_BAR; PG8_MMA(1, 1, At, B1); PG8_BAR;
        }
        E(acc, cur, wr, wc, fr, fq); S.done(cur);
        if (!has_next) break;
#pragma unroll
        for (int a = 0; a < 2; ++a)
#pragma unroll
            for (int b = 0; b < 2; ++b)
#pragma unroll
                for (int m = 0; m < 4; ++m)
#pragma unroll
                    for (int n = 0; n < 2; ++n) acc[a][b][m][n] = (f32x4){0.f, 0.f, 0.f, 0.f};
        cur = nxt; cA = nA; cB = nB; ++ui;
    }
    PG8_WAIT_V(0);
    if (wr == 0) PG8_BAR;
    PG8_BAR;
#undef PG8_SA
#undef PG8_SB
#undef PG8_STAGE
#undef PG8_LDA
#undef PG8_LDB
#undef PG8_MMA
#undef PG8_WAIT_V
#undef PG8_WAIT_L
#undef PG8_BAR
#undef PG8_SCHED
}
}

using AccT = f32x4[2][2][4][2];
#define EPI_ROWS_BEGIN                                                                     \
  _Pragma("unroll") for (int ai = 0; ai < 2; ++ai) _Pragma("unroll") for (int m = 0; m < 4; ++m) { \
    const int row = rowbase + ai * 128 + m * 16;
#define EPI_ROWS_END }

#define EPI_RLOOP _Pragma("unroll") for (int ai = 0; ai < 2; ++ai) _Pragma("unroll") for (int m = 0; m < 4; ++m)
#define EPI_CLOOP _Pragma("unroll") for (int bj = 0; bj < 2; ++bj) _Pragma("unroll") for (int n = 0; n < 2; ++n)
struct EpiSwiglu {
  static constexpr bool PERM = false, AFTER_DRAIN = false;
  bf16_t* U;
  DEVINL void operator()(const AccT& acc, const pg8::Unit& u, int wr, int wc, int fr, int fq) const {
    const int rowbase = u.pm * 256 + wr * 64 + fr;
#pragma unroll
    for (int bj = 0; bj < 2; ++bj) {
      const int ucol = ((u.pn * 256 + bj * 128 + wc * 32) >> 5) * 16 + 4 * fq;
      EPI_RLOOP {
        const int row = rowbase + ai * 128 + m * 16;
        f32x4 a = acc[ai][bj][m][0], b = acc[ai][bj][m][1];
        uint2 pk; pk.x = pk2(silu(a[0]) * b[0], silu(a[1]) * b[1]); pk.y = pk2(silu(a[2]) * b[2], silu(a[3]) * b[3]);
        *(uint2*)(U + (size_t)row * FF + ucol) = pk;
      }
    }
  }
};
struct EpiResid {
  static constexpr bool PERM = false, AFTER_DRAIN = false;
  float* X; const float* Mod; int ml, mj; float gs;
  DEVINL void operator()(const AccT& acc, const pg8::Unit& u, int wr, int wc, int fr, int fq) const {
    const int rowbase = u.pm * 256 + wr * 64 + fr;
    const int bq = u.pm / 9, mr = (u.pm - bq * 9 == 0) ? 16 : bq;
    const float* gv = Mod + (size_t)(ml * 17 + mr) * 9216 + mj * 1024;
    EPI_CLOOP {
      const int col = u.pn * 256 + bj * 128 + wc * 32 + n * 16 + 4 * fq;
      const f32x4 g4 = *(const f32x4*)(gv + col) * gs;
      EPI_RLOOP {
        const int row = rowbase + ai * 128 + m * 16;
        float* xp = X + (size_t)row * 1024 + col;
        f32x4 x = *(const f32x4*)xp;
        *(f32x4*)xp = x * ALPHA + g4 * acc[ai][bj][m][n];
        if (m & 1) __builtin_amdgcn_sched_barrier(0);
      }
    }
  }
};
struct EpiPin {
  static constexpr bool PERM = false, AFTER_DRAIN = false;
  bf16_t* PRWp; bf16_t* PRp;
  DEVINL void operator()(const AccT& acc, const pg8::Unit& u, int wr, int wc, int fr, int fq) const {
    const int rowbase = u.pm * 256 + wr * 64 + fr;
    EPI_CLOOP {
      const int col = u.pn * 256 + bj * 128 + wc * 32 + n * 16 + 4 * fq;
      EPI_RLOOP {
        const int row = rowbase + ai * 128 + m * 16;
        f32x4 v = acc[ai][bj][m][n];
        uint2 pk; pk.x = pk2(v[0], v[1]); pk.y = pk2(v[2], v[3]);
        if (col < PRW) *(uint2*)(PRWp + (size_t)row * PRW + col) = pk;
        else if (col < 3616) *(uint2*)(PRp + (size_t)row * PREST + (col - PRW)) = pk;
      }
    }
  }
};
struct EpiLora {
  static constexpr bool PERM = false, AFTER_DRAIN = false;
  bf16_t* Lo; const float* w0; const float* a0;
  DEVINL void operator()(const AccT& acc, const pg8::Unit& u, int wr, int wc, int fr, int fq) const {
    const int rowbase = u.pm * 256 + wr * 64 + fr;
    EPI_CLOOP {
      const int col = u.pn * 256 + bj * 128 + wc * 32 + n * 16 + 4 * fq;
      f32x4 b4 = (f32x4){0.f, 0.f, 0.f, 0.f};
      if (u.pn < 2) b4 = *(const f32x4*)(w0 + col);
      else if (u.pn < 4) b4 = *(const f32x4*)(a0 + (col - 512));
      EPI_RLOOP {
        const int row = rowbase + ai * 128 + m * 16;
        f32x4 v = acc[ai][bj][m][n] + b4;
        if (u.pn < 2) {
#pragma unroll
          for (int i = 0; i < 4; ++i) v[i] = 1.f - __expf(-0.6065306597126334f * sigm(v[i]));
        } else if (u.pn < 4) {
#pragma unroll
          for (int i = 0; i < 4; ++i) v[i] = sigm(v[i]);
        }
        uint2 pk; pk.x = pk2(v[0], v[1]); pk.y = pk2(v[2], v[3]);
        *(uint2*)(Lo + (size_t)row * 1280 + col) = pk;
      }
    }
  }
};
struct EpiGlu {
  static constexpr bool PERM = false, AFTER_DRAIN = false;
  const bf16_t* Yin; bf16_t* Yc; const float* bg;
  DEVINL void operator()(const AccT& acc, const pg8::Unit& u, int wr, int wc, int fr, int fq) const {
    const int rowbase = u.pm * 256 + wr * 64 + fr;
    EPI_CLOOP {
      const int col = bj * 128 + wc * 32 + n * 16 + 4 * fq;
      const f32x4 b4 = *(const f32x4*)(bg + col);
      EPI_RLOOP {
        const int row = rowbase + ai * 128 + m * 16;
        uint2 yr = *(const uint2*)(Yin + (size_t)row * 256 + col);
        f32x4 v = acc[ai][bj][m][n] + b4;
        float y0 = bf2f((bf16_t)(yr.x & 0xffff)), y1 = bf2f((bf16_t)(yr.x >> 16)), y2 = bf2f((bf16_t)(yr.y & 0xffff)), y3 = bf2f((bf16_t)(yr.y >> 16));
        uint2 pk; pk.x = pk2(y0 * sigm(v[0]), y1 * sigm(v[1])); pk.y = pk2(y2 * sigm(v[2]), y3 * sigm(v[3]));
        *(uint2*)(Yc + (size_t)row * 256 + col) = pk;
      }
    }
  }
};
struct EpiBranch {
  static constexpr bool PERM = false, AFTER_DRAIN = false;
  bf16_t* Br;
  DEVINL void operator()(const AccT& acc, const pg8::Unit& u, int wr, int wc, int fr, int fq) const {
    const int nb = u.pm / 144, pmr = u.pm - nb * 144;
    const int rowbase = pmr * 256 + wr * 64 + fr;
    EPI_CLOOP {
      const int col = u.pn * 256 + bj * 128 + wc * 32 + n * 16 + 4 * fq;
      EPI_RLOOP {
        const int row = rowbase + ai * 128 + m * 16;
        f32x4 v = acc[ai][bj][m][n];
        uint2 pk; pk.x = pk2(v[0], v[1]); pk.y = pk2(v[2], v[3]);
        *(uint2*)(Br + (size_t)row * 4096 + col) = pk;
      }
    }
  }
};
struct EpiGate {
  static constexpr bool PERM = false, AFTER_DRAIN = false;
  bf16_t* Br; const float* bgate;
  DEVINL void operator()(const AccT& acc, const pg8::Unit& u, int wr, int wc, int fr, int fq) const {
    const int rowbase = u.pm * 256 + wr * 64 + fr;
    EPI_CLOOP {
      const int col = u.pn * 256 + bj * 128 + wc * 32 + n * 16 + 4 * fq;
      const f32x4 b4 = *(const f32x4*)(bgate + col);
      EPI_RLOOP {
        const int row = rowbase + ai * 128 + m * 16;
        bf16_t* bp = Br + (size_t)row * 4096 + col;
        uint2 br = *(const uint2*)bp;
        f32x4 v = acc[ai][bj][m][n] + b4;
        float y0 = bf2f((bf16_t)(br.x & 0xffff)), y1 = bf2f((bf16_t)(br.x >> 16)), y2 = bf2f((bf16_t)(br.y & 0xffff)), y3 = bf2f((bf16_t)(br.y >> 16));
        uint2 pk; pk.x = pk2(y0 * sigm(v[0]), y1 * sigm(v[1])); pk.y = pk2(y2 * sigm(v[2]), y3 * sigm(v[3]));
        *(uint2*)bp = pk;
      }
    }
  }
};

template <class Epi, class Order = pg8::StaticOrder>
DEVINL void run_gemm(int wave, unsigned char* smem, const bf16_t* A, const bf16_t* Bt, int Mo, int N, int K, const Epi& E, int skip = 0) {
  asm volatile("" : "+s"(K), "+s"(N), "+s"(Mo));
  Order S; S.init(Mo, N, gridDim.x, blockIdx.x, skip);
  pg8::gemm_phase<Epi, Order>(wave, (PG8_LAS unsigned char*)smem, pg8::Gemm{A, Bt, Mo, N, K}, S, E);
}

#define XB_TMO      128
#define XB_XCNT(j)  (256  + 64 * (j))
#define XB_XSUB(j)  (1280 + 64 * (j))
#define XB_XGEN(j)  (2304 + 64 * (j))
#define XB_TOP      3328
#define XB_TOPGEN   3392
#define XCD_BAR_WORDS 3456
#define XB_SPIN_CAP (1u << 18)
#define XLAS __attribute__((address_space(3)))
DEVINL unsigned xb_ld(unsigned* p)              { return __hip_atomic_load(p, __ATOMIC_RELAXED, __HIP_MEMORY_SCOPE_AGENT); }
DEVINL unsigned xb_add(unsigned* p, unsigned v) { return __hip_atomic_fetch_add(p, v, __ATOMIC_RELAXED, __HIP_MEMORY_SCOPE_AGENT); }
DEVINL unsigned xb_xcc_id() { return (unsigned)__builtin_amdgcn_s_getreg((3 << 11) | 20) & 0xFu; }
#define XB_SPIN(cond, bar) do { unsigned _sp = 0; while (cond) { __builtin_amdgcn_s_sleep(1); \
    if ((++_sp & 255u) == 0u) { if (xb_ld(&(bar)[XB_TMO])) break; if (_sp > XB_SPIN_CAP) { atomicAdd(&(bar)[XB_TMO], 1u); break; } } } } while (0)
struct XcdBarrier { unsigned* bar; unsigned x; volatile XLAS unsigned* st; int wave; };
DEVINL XcdBarrier xcd_barrier_post(int wave, unsigned* bar, volatile XLAS unsigned* st) {
    XcdBarrier b; b.bar = bar; b.x = xb_xcc_id(); b.st = st; b.wave = wave;
    if (otid(wave) == 0) (void)xb_add(&bar[XB_XCNT(b.x)], 1u);
    return b;
}
DEVINL void xcd_barrier_complete(unsigned* bar, unsigned x, unsigned& nloc, unsigned& nx) {
    const unsigned G = gridDim.x * gridDim.y * gridDim.z;
    unsigned sum, cnt, mine, sp = 0u;
    for (;;) {
        sum = 0u; cnt = 0u; mine = 0u;
#pragma unroll
        for (unsigned j = 0; j < 16; ++j) { const unsigned c = xb_ld(&bar[XB_XCNT(j)]); sum += c; cnt += (c > 0u) ? 1u : 0u; mine = (j == x) ? c : mine; }
        if (sum == G) break;
        __builtin_amdgcn_s_sleep(1);
        if ((++sp & 255u) == 0u) { if (xb_ld(&bar[XB_TMO])) break; if (sp > XB_SPIN_CAP) { atomicAdd(&bar[XB_TMO], 1u); break; } }
    }
    nloc = mine > 0u ? mine : 1u; nx = cnt > 0u ? cnt : 1u;
}
DEVINL void xcd_barrier(const Params& p, unsigned char* smem) {
    XcdBarrier b; b.bar = (unsigned*)(p.ws + OFF_BAR); b.x = xb_xcc_id(); b.st = (volatile XLAS unsigned*)(XLAS unsigned char*)(smem + 131072); b.wave = p.wave;
    asm volatile("s_waitcnt vmcnt(0)" ::: "memory");
    __syncthreads();
    if (otid(b.wave) == 0) {
        unsigned* bar = b.bar;
        __builtin_amdgcn_s_waitcnt(0);
        unsigned nloc = b.st[0], nx = b.st[1];
        if (nloc == 0u) { xcd_barrier_complete(bar, b.x, nloc, nx); b.st[0] = nloc; b.st[1] = nx; }
        const unsigned old = xb_add(&bar[XB_XSUB(b.x)], 1u);
        const unsigned gen = old / nloc;
        if (old + 1u == (gen + 1u) * nloc) {
            __builtin_amdgcn_fence(__ATOMIC_RELEASE, "agent");
            asm volatile("s_waitcnt vmcnt(0)" ::: "memory");
            const unsigned og = xb_add(&bar[XB_TOP], 1u);
            const unsigned tg = og / nx;
            if (og + 1u == (tg + 1u) * nx) xb_add(&bar[XB_TOPGEN], 1u);
            else XB_SPIN(xb_ld(&bar[XB_TOPGEN]) == tg, bar);
            __builtin_amdgcn_fence(__ATOMIC_ACQUIRE, "agent");
            xb_add(&bar[XB_XGEN(b.x)], 1u);
            asm volatile("s_waitcnt vmcnt(0)" ::: "memory");
        } else {
            XB_SPIN(xb_ld(&bar[XB_XGEN(b.x)]) == gen, bar);
            __builtin_amdgcn_fence(__ATOMIC_ACQUIRE, "agent");
            asm volatile("s_waitcnt vmcnt(0)" ::: "memory");
        }
    }
    __syncthreads();
}

DEVINL void phase_lnmod(const Params& p, bool from_input, bool do_ln, int lnl, int lnj, int ml, int mj,
                        bf16_t* H, bool final_out, bool skipctx = false) {
  char* ws = p.ws;
  float* X = (float*)(ws + OFF_X);
  const float* Mod = (const float*)(ws + OFF_MOD);
  const int lane = otid(p.wave) & 63, wid = otid(p.wave) >> 6;
  const int gw = blockIdx.x * 8 + wid, nw = gridDim.x * 8;
  const float* g = p.in[6] + (size_t)(lnl * 3 + lnj) * 1024;
  const float* bb = p.in[7] + (size_t)(lnl * 3 + lnj) * 1024;
  for (int row = gw; row < MROWS; row += nw) {
    int b = row / SEQT, pos = row - b * SEQT;
    if (skipctx && pos < 256) continue;
    int mr = pos < 256 ? 16 : b;
    const float* src;
    if (from_input) src = (pos < 256) ? (p.in[2] + (size_t)(b * 256 + pos) * 1024) : (p.in[0] + (size_t)(b * 2048 + pos - 256) * 1024);
    else src = X + (size_t)row * 1024;
    float4 v[4];
#pragma unroll
    for (int i = 0; i < 4; ++i) v[i] = *(const float4*)(src + i * 256 + lane * 4);
    if (do_ln) {
      float s = 0.f;
#pragma unroll
      for (int i = 0; i < 4; ++i) s += v[i].x + v[i].y + v[i].z + v[i].w;
      float mean = wave_sum(s) * (1.f / 1024.f);
      float q = 0.f;
#pragma unroll
      for (int i = 0; i < 4; ++i) {
        v[i].x -= mean; v[i].y -= mean; v[i].z -= mean; v[i].w -= mean;
        q += v[i].x * v[i].x + v[i].y * v[i].y + v[i].z * v[i].z + v[i].w * v[i].w;
      }
      float rs = rsqrtf(wave_sum(q) * (1.f / 1024.f) + 1e-5f);
#pragma unroll
      for (int i = 0; i < 4; ++i) {
        float4 gg = *(const float4*)(g + i * 256 + lane * 4);
        float4 b4 = *(const float4*)(bb + i * 256 + lane * 4);
        v[i].x = v[i].x * rs * gg.x + b4.x; v[i].y = v[i].y * rs * gg.y + b4.y;
        v[i].z = v[i].z * rs * gg.z + b4.z; v[i].w = v[i].w * rs * gg.w + b4.w;
      }
    }
    if (final_out) {
      if (pos >= 256) {
        float* o = p.out + (size_t)(b * 2048 + pos - 256) * 1024;
#pragma unroll
        for (int i = 0; i < 4; ++i) *(float4*)(o + i * 256 + lane * 4) = v[i];
      }
    } else {
      const float* sh = Mod + (size_t)(ml * 17 + mr) * 9216 + mj * 1024;
      const float* sc = sh + 1024;
#pragma unroll
      for (int i = 0; i < 4; ++i) {
        if (from_input || do_ln) *(float4*)(X + (size_t)row * 1024 + i * 256 + lane * 4) = v[i];
        float4 s4 = *(const float4*)(sh + i * 256 + lane * 4);
        float4 c4 = *(const float4*)(sc + i * 256 + lane * 4);
        unsigned h0 = f2bf(v[i].x * (1.f + c4.x) + s4.x), h1 = f2bf(v[i].y * (1.f + c4.y) + s4.y);
        unsigned h2 = f2bf(v[i].z * (1.f + c4.z) + s4.z), h3 = f2bf(v[i].w * (1.f + c4.w) + s4.w);
        uint2 pk; pk.x = h0 | (h1 << 16); pk.y = h2 | (h3 << 16);
        *(uint2*)(H + (size_t)row * 1024 + i * 256 + lane * 4) = pk;
      }
    }
  }
}

DEVINL void phase_ada_partial(const Params& p, float* smf) {
  float* MODP = (float*)(p.ws + OFF_AR + AR_MODP);
  const int tid = otid(p.wave) & 255, half = otid(p.wave) >> 8;
  float* sm = smf + half * 5120;
  for (int it0 = blockIdx.x * 2; it0 < 576; it0 += gridDim.x * 2) {
    int it = it0 + half; bool valid = it < 576; if (!valid) it = 575;
    int kq = it & 3, cb = it >> 2;
    int col = cb * 256 + tid;
    int l = col / 9216, n = col - l * 9216;
    for (int idx = tid; idx < 256 * 17; idx += 256) {
      int r = idx >> 8, k = idx & 255;
      float val = (r < 16) ? p.in[1][r * 1024 + kq * 256 + k] : p.in[3][kq * 256 + k];
      sm[k * 20 + r] = silu(val);
    }
    __syncthreads();
    float acc[17];
#pragma unroll
    for (int r = 0; r < 17; ++r) acc[r] = 0.f;
    const float* w = p.in[4] + ((size_t)l * 1024 + kq * 256) * 9216 + n;
#pragma unroll 4
    for (int k = 0; k < 256; ++k) {
      float wv = w[(size_t)k * 9216];
      const float4* s4 = (const float4*)(sm + k * 20);
      float4 a0 = s4[0], a1 = s4[1], a2 = s4[2], a3 = s4[3];
      float a16 = sm[k * 20 + 16];
      acc[0] += a0.x * wv; acc[1] += a0.y * wv; acc[2] += a0.z * wv; acc[3] += a0.w * wv;
      acc[4] += a1.x * wv; acc[5] += a1.y * wv; acc[6] += a1.z * wv; acc[7] += a1.w * wv;
      acc[8] += a2.x * wv; acc[9] += a2.y * wv; acc[10] += a2.z * wv; acc[11] += a2.w * wv;
      acc[12] += a3.x * wv; acc[13] += a3.y * wv; acc[14] += a3.z * wv; acc[15] += a3.w * wv;
      acc[16] += a16 * wv;
    }
    if (valid) {
#pragma unroll
      for (int r = 0; r < 17; ++r) MODP[((size_t)(kq * 4 + l) * 17 + r) * 9216 + n] = acc[r];
    }
    __syncthreads();
  }
}

DEVINL void phase_ada_reduce(const Params& p) {
  const float* MODP = (const float*)(p.ws + OFF_AR + AR_MODP);
  float* Mod = (float*)(p.ws + OFF_MOD);
  const int total = 4 * 17 * 9216;
  for (int idx = blockIdx.x * 512 + otid(p.wave); idx < total; idx += gridDim.x * 512) {
    int n = idx % 9216; int l = idx / (17 * 9216);
    float s = p.in[5][l * 9216 + n];
#pragma unroll
    for (int kq = 0; kq < 4; ++kq) s += MODP[(size_t)kq * total + idx];
    Mod[idx] = s;
  }
}

DEVINL void phase_tables(const Params& p) {
  float* TAB = (float*)(p.ws + OFF_TAB);
  int idx = blockIdx.x * 512 + otid(p.wave);
  if (idx < 1024) {
    int n = idx >> 4, j = idx & 15;
    float inv = powf(10000.f, -(float)j / 16.f);
    float ang = (float)n * inv;
    TAB[idx] = cosf(ang);
    TAB[1024 + idx] = sinf(ang);
  } else if (idx < 1280) {
    int c = idx - 1024;
    const float* lg = p.in[33];
    float v0 = lg[c], v1 = lg[256 + c], v2 = lg[512 + c], v3 = lg[768 + c];
    float mx = fmaxf(fmaxf(v0, v1), fmaxf(v2, v3));
    float e0 = expf(v0 - mx), e1 = expf(v1 - mx), e2 = expf(v2 - mx), e3 = expf(v3 - mx);
    float inv = 1.f / (e0 + e1 + e2 + e3);
    float s0 = e0 * inv, s1 = e1 * inv, s2 = e2 * inv, s3 = e3 * inv;
    float c0 = s0, c1 = c0 + s1, c2 = c1 + s2, c3 = c2 + s3;
    TAB[2048 + c] = c0 - s0;
    TAB[2048 + 256 + c] = c1 - s0;
    TAB[2048 + 512 + c] = c2 - s0;
    TAB[2048 + 768 + c] = c3 - s0;
  }
}


struct F4 { float a, b, c, d; };
DEVINL F4 ld4bf(const bf16_t* p) { uint2 r = *(const uint2*)p; F4 o; o.a = __uint_as_float(r.x << 16); o.b = __uint_as_float(r.x & 0xffff0000u); o.c = __uint_as_float(r.y << 16); o.d = __uint_as_float(r.y & 0xffff0000u); return o; }
DEVINL void st4bf(bf16_t* p, float a, float b, float c, float d) { uint2 r; r.x = pk2(a, b); r.y = pk2(c, d); *(uint2*)p = r; }
DEVINL F4 ld4f(const float* p) { float4 r = *(const float4*)p; F4 o; o.a = r.x; o.b = r.y; o.c = r.z; o.d = r.w; return o; }
DEVINL float row16_sum(float x) {
  x += __int_as_float(__builtin_amdgcn_update_dpp(0, __float_as_int(x), 0xB1, 0xF, 0xF, true));
  x += __int_as_float(__builtin_amdgcn_update_dpp(0, __float_as_int(x), 0x4E, 0xF, 0xF, true));
  x += __int_as_float(__builtin_amdgcn_update_dpp(0, __float_as_int(x), 0x141, 0xF, 0xF, true));
  x += __int_as_float(__builtin_amdgcn_update_dpp(0, __float_as_int(x), 0x140, 0xF, 0xF, true));
  return x;
}
DEVINL void phase_shift(const Params& p, int l) {
  char* ws = p.ws;
  const bf16_t* PRWp = (const bf16_t*)(ws + OFF_AR + AR_PRW);
  bf16_t* RKV = (bf16_t*)(ws + OFF_AR + AR_RKV);
  bf16_t* A2 = (bf16_t*)(ws + OFF_AR + AR_A2);
  const float* mu = p.in[12] + (size_t)l * PRW;
  bf16_t* PRp = (bf16_t*)(ws + OFF_AR + AR_PREST);
  const float* TABp = (const float*)(ws + OFF_TAB);
  const int lane = otid(p.wave) & 63, wid = otid(p.wave) >> 6;
  const int gw = blockIdx.x * 8 + wid, nw = gridDim.x * 8;
  const int c4 = lane * 4;
  for (int row = gw; row < MROWS; row += nw) {
    int b = row / SEQT, pos = row - b * SEQT;
    const bool hasp = !(pos == 0 || pos == 256);
    const bool hasn = !(pos == 255 || pos == 2303);
    const bf16_t* pr = PRWp + (size_t)row * PRW;
#pragma unroll
    for (int it = 0; it < 5; ++it) {
      const int c = it * 256 + c4;
      if (it < 4 || lane < 8) {
        F4 x0 = ld4bf(pr + c);
        F4 xp = {0.f, 0.f, 0.f, 0.f}, xn = {0.f, 0.f, 0.f, 0.f};
        if (hasp) xp = ld4bf(pr + c - PRW);
        if (hasn) xn = ld4bf(pr + c + PRW);
        F4 m = ld4f(mu + c);
        float s0 = x0.a + m.a * (0.5f * (xp.a + xn.a) - x0.a);
        float s1 = x0.b + m.b * (0.5f * (xp.b + xn.b) - x0.b);
        float s2 = x0.c + m.c * (0.5f * (xp.c + xn.c) - x0.c);
        float s3 = x0.d + m.d * (0.5f * (xp.d + xn.d) - x0.d);
        if (it < 3) {
          st4bf(RKV + (size_t)row * 1024 + c, s0, s1, s2, s3);
          if (it == 1) {
            F4 kc = ld4f(p.in[18] + l * 256 + (c - 256));
            float k0 = s0 * kc.a, k1 = s1 * kc.b, k2 = s2 * kc.c, k3 = s3 * kc.d;
            float nrm = row16_sum(k0 * k0 + k1 * k1 + k2 * k2 + k3 * k3);
            float rs = rsqrtf(fmaxf(nrm, 1e-12f));
            st4bf(RKV + (size_t)row * 1024 + 512 + c, k0 * rs, k1 * rs, k2 * rs, k3 * rs);
          }
        } else if (c < 832) st4bf(A2 + (size_t)row * 384 + (c - 768), tanh_fast(s0), tanh_fast(s1), tanh_fast(s2), tanh_fast(s3));
        else if (c < 896) st4bf(A2 + (size_t)row * 384 + (c - 768), s0, s1, s2, s3);
        else st4bf(A2 + (size_t)row * 384 + 128 + (c - 896), sigm(s0), sigm(s1), sigm(s2), sigm(s3));
      }
    }
    if (lane < 24) *(uint2*)(A2 + (size_t)row * 384 + 288 + c4) = make_uint2(0u, 0u);
    {
      bf16_t* prr = PRp + (size_t)row * PREST;
      const int d = c4 & 63, jj = d & 31, fi = jj & 15;
      F4 cs = {1.f, 1.f, 1.f, 1.f}, sn = {0.f, 0.f, 0.f, 0.f};
      if (pos >= 256) {
        const int t = pos - 256; const int n = jj < 16 ? (t >> 6) : (t & 63);
        cs = ld4f(TABp + n * 16 + fi); sn = ld4f(TABp + 1024 + n * 16 + fi);
      }
      const int cp = c4 ^ 32;
      F4 xq = ld4bf(prr + c4), xqp = ld4bf(prr + cp), xk = ld4bf(prr + 256 + c4), xkp = ld4bf(prr + 256 + cp);
      const float sg = (d < 32) ? -1.f : 1.f;
      asm volatile("" ::: "memory");
      st4bf(prr + c4, xq.a * cs.a + sg * xqp.a * sn.a, xq.b * cs.b + sg * xqp.b * sn.b, xq.c * cs.c + sg * xqp.c * sn.c, xq.d * cs.d + sg * xqp.d * sn.d);
      st4bf(prr + 256 + c4, 0.125f * (xk.a * cs.a + sg * xkp.a * sn.a), 0.125f * (xk.b * cs.b + sg * xkp.b * sn.b),
            0.125f * (xk.c * cs.c + sg * xkp.c * sn.c), 0.125f * (xk.d * cs.d + sg * xkp.d * sn.d));
      F4 lb = ld4f(TABp + 2048 + l * 256 + c4);
      F4 zf = ld4bf(prr + 1536 + c4), zb = ld4bf(prr + 1792 + c4);
      F4 f0 = ld4f(p.in[34] + (l * 2 + 0) * 256 + c4), f1 = ld4f(p.in[34] + (l * 2 + 1) * 256 + c4);
      st4bf(prr + 1536 + c4, (1.f - lb.a) * sigm(-(zf.a + f0.a)), (1.f - lb.b) * sigm(-(zf.b + f0.b)), (1.f - lb.c) * sigm(-(zf.c + f0.c)), (1.f - lb.d) * sigm(-(zf.d + f0.d)));
      st4bf(prr + 1792 + c4, (1.f - lb.a) * sigm(-(zb.a + f1.a)), (1.f - lb.b) * sigm(-(zb.b + f1.b)), (1.f - lb.c) * sigm(-(zb.c + f1.c)), (1.f - lb.d) * sigm(-(zb.d + f1.d)));
    }
  }
}

DEVINL int vrow(int b, int dir, int pp) {
  int pos = dir ? (pp < 256 ? 255 - pp : 2559 - pp) : pp;
  return b * SEQT + pos;
}

typedef float v2f __attribute__((ext_vector_type(2)));
#ifdef NOSB
#define SB()
#else
#define SB() __builtin_amdgcn_sched_barrier(0)
#endif
#define LO2(t) __builtin_shufflevector(t, t, 0, 1)
#define HI2(t) __builtin_shufflevector(t, t, 2, 3)
DEVINL void wave_lds_sync() {
  __builtin_amdgcn_fence(__ATOMIC_RELEASE, "wavefront");
  __builtin_amdgcn_wave_barrier();
  __builtin_amdgcn_fence(__ATOMIC_ACQUIRE, "wavefront");
}

DEVINL float dpp_xor1(float x) { return __int_as_float(__builtin_amdgcn_update_dpp(0, __float_as_int(x), 0xB1, 0xF, 0xF, true)); }
DEVINL float dpp_xor2(float x) { return __int_as_float(__builtin_amdgcn_update_dpp(0, __float_as_int(x), 0x4E, 0xF, 0xF, true)); }

typedef _Float16 h2 __attribute__((ext_vector_type(2)));
typedef _Float16 h8 __attribute__((ext_vector_type(8)));
#define H2(q, j) (h2{(q)[2 * (j)], (q)[2 * (j) + 1]})
DEVINL void scan_rwkv(const Params& p, int l, int b, int dir, int h, int quarter, int lane, float* sw) {
  asm volatile("" : "+v"(lane));
  __builtin_amdgcn_s_setprio(3);
  char* ws = p.ws;
  const bf16_t* RKV = (const bf16_t*)(ws + OFF_AR + AR_RKV);
  const bf16_t* L = (const bf16_t*)(ws + OFF_AR + AR_L);
  bf16_t* O = (bf16_t*)(ws + OFF_AR + AR_OUT) + (size_t)(dir ? 4 : 0) * OUTSLOT;
  const int c = h * 64 + lane;
  const int kp = lane & 3, myrow = quarter * 16 + (lane >> 2);
  const float kac = p.in[19][l * 256 + c];
  h2 S[8];
#pragma unroll
  for (int k = 0; k < 8; ++k) S[k] = h2{(_Float16)0.f, (_Float16)0.f};
  bf16_t rr[8], rk[8], rv[8], rkk[8], rw[8], ra[8];
#define RWKV_LOADRAW(CH)                                                  \
  _Pragma("unroll") for (int s = 0; s < 8; ++s) {                         \
    int row = vrow(b, dir, (CH) * 8 + s);                                 \
    rr[s] = RKV[(size_t)row * 1024 + c];                                  \
    rk[s] = RKV[(size_t)row * 1024 + 256 + c];                            \
    rv[s] = RKV[(size_t)row * 1024 + 512 + c];                            \
    rkk[s] = RKV[(size_t)row * 1024 + 768 + c];                           \
    rw[s] = L[(size_t)row * 1280 + dir * 256 + c];                        \
    ra[s] = L[(size_t)row * 1280 + 512 + dir * 256 + c];                  \
  }
#define RWKV_LD(Q, VV, S_)                                                              \
  { const float* base_ = sw + (S_) * 224;                                               \
    _Pragma("unroll") for (int a = 0; a < 5; ++a) {                                     \
      Q[2 * a] = *(const h8*)(base_ + a * 32 + kp * 8);                                 \
      Q[2 * a + 1] = *(const h8*)(base_ + a * 32 + kp * 8 + 4); }                       \
    VV = base_[160 + myrow]; }
#define RWKV_CMP(Q, VV, S_)                                                             \
  { h2 sa0 = h2{(_Float16)0.f, (_Float16)0.f}, sa1 = sa0;                               \
    _Pragma("unroll") for (int i = 0; i < 4; ++i) { sa0 += S[i] * H2(Q[0], i); sa1 += S[4 + i] * H2(Q[1], i); } \
    float sa = ((float)sa0.x + (float)sa0.y) + ((float)sa1.x + (float)sa1.y);           \
    sa += dpp_xor1(sa); sa += dpp_xor2(sa);                                             \
    const h2 sasa = h2{(_Float16)sa, (_Float16)sa}, vv = h2{(_Float16)(VV), (_Float16)(VV)}; \
    h2 y0 = h2{(_Float16)0.f, (_Float16)0.f}, y1 = y0;                                  \
    _Pragma("unroll") for (int g = 0; g < 2; ++g) _Pragma("unroll") for (int i = 0; i < 4; ++i) { \
      const h2 nw = H2(Q[2 + g], i), bq = H2(Q[4 + g], i), dq = H2(Q[6 + g], i), rq = H2(Q[8 + g], i); \
      const h2 t = vv * dq - sasa * bq;                                                 \
      const h2 u = S[4 * g + i] + t;                                                    \
      S[4 * g + i] = S[4 * g + i] * nw + u;                                             \
      if (g == 0) y0 += S[4 * g + i] * rq; else y1 += S[4 * g + i] * rq;                \
    }                                                                                   \
    float y = ((float)y0.x + (float)y0.y) + ((float)y1.x + (float)y1.y);                \
    y += dpp_xor1(y); y += dpp_xor2(y);                                                 \
    if (kp == 0) { int row = vrow(b, dir, ch * 8 + (S_)); O[(size_t)row * 256 + h * 64 + myrow] = f2bf(y); } }
  RWKV_LOADRAW(0)
#pragma unroll 1
  for (int ch = 0; ch < 288; ++ch) {
#pragma unroll
    for (int s = 0; s < 8; ++s) {
      float r_ = bf2f(rr[s]), k_ = bf2f(rk[s]), v_ = bf2f(rv[s]), kk_ = bf2f(rkk[s]);
      float omw = bf2f(rw[s]), a_ = bf2f(ra[s]);
      float kd_ = k_ * (1.f + (a_ - 1.f) * kac);
      _Float16* q = (_Float16*)(sw + s * 224);
      q[lane] = (_Float16)kk_; q[64 + lane] = (_Float16)(-omw); q[128 + lane] = (_Float16)(kk_ * a_); q[192 + lane] = (_Float16)kd_; q[256 + lane] = (_Float16)r_;
      sw[s * 224 + 160 + lane] = v_;
    }
    wave_lds_sync();
    if (ch + 1 < 288) { RWKV_LOADRAW(ch + 1) }
    SB();
    h8 QA[10], QB[10]; float vA, vB;
    RWKV_LD(QA, vA, 0) SB();
    RWKV_LD(QB, vB, 1) SB(); RWKV_CMP(QA, vA, 0) SB();
    RWKV_LD(QA, vA, 2) SB(); RWKV_CMP(QB, vB, 1) SB();
    RWKV_LD(QB, vB, 3) SB(); RWKV_CMP(QA, vA, 2) SB();
    RWKV_LD(QA, vA, 4) SB(); RWKV_CMP(QB, vB, 3) SB();
    RWKV_LD(QB, vB, 5) SB(); RWKV_CMP(QA, vA, 4) SB();
    RWKV_LD(QA, vA, 6) SB(); RWKV_CMP(QB, vB, 5) SB();
    RWKV_LD(QB, vB, 7) SB(); RWKV_CMP(QA, vA, 6) SB();
    RWKV_CMP(QB, vB, 7) SB();
    wave_lds_sync();
  }
  __builtin_amdgcn_s_setprio(0);
#undef RWKV_LOADRAW
#undef RWKV_LD
#undef RWKV_CMP
}

template <int MODE>
DEVINL void scan_gla(const Params& p, int l, int b, int dir, int h, int quarter, int lane, float* sw) {
  asm volatile("" : "+v"(lane));
  __builtin_amdgcn_s_setprio(3);
  char* ws = p.ws;
  const bf16_t* PR = (const bf16_t*)(ws + OFF_AR + AR_PREST);
  bf16_t* O = (bf16_t*)(ws + OFF_AR + AR_OUT) + (size_t)(MODE == 0 ? (dir ? 6 : 3) : (dir ? 5 : 1)) * OUTSLOT;
  const int c = h * 64 + lane;
  const int dp = lane & 3, mycol = quarter * 16 + (lane >> 2);
  const float gamma = 1.f - exp2f(-5.f - (float)h);
  const h2 g2 = h2{(_Float16)gamma, (_Float16)gamma};
  h2 S[8];
#pragma unroll
  for (int k = 0; k < 8; ++k) S[k] = h2{(_Float16)0.f, (_Float16)0.f};
  bf16_t r0[8], r1[8], r2[8];
  const int cA = (MODE == 0) ? ((dir ? 1792 : 1536) + c) : (256 + c);
  const int cQ = (MODE == 0) ? (1280 + c) : c;
  const int cV = (MODE == 0) ? (2048 + c) : (512 + c);
#define GLA_LOADRAW(CH)                                                              \
  _Pragma("unroll") for (int s = 0; s < 8; ++s) {                                    \
    int row = vrow(b, dir, (CH) * 8 + s);                                            \
    const bf16_t* pr = PR + (size_t)row * PREST;                                     \
    r0[s] = pr[cA]; r1[s] = pr[cQ]; r2[s] = pr[cV];                                  \
  }
#define GLA_LD(Q, VV, S_)                                                            \
  { const float* base_ = sw + (S_) * 128;                                            \
    Q[0] = *(const h8*)(base_ + dp * 8); Q[1] = *(const h8*)(base_ + dp * 8 + 4);    \
    Q[2] = *(const h8*)(base_ + 32 + dp * 8); Q[3] = *(const h8*)(base_ + 32 + dp * 8 + 4); \
    VV = base_[64 + mycol]; }
#define GLA_CMP(Q, VV, S_)                                                           \
  { const h2 vv = h2{(_Float16)(VV), (_Float16)(VV)}; h2 o0 = h2{(_Float16)0.f, (_Float16)0.f}, o1 = o0; \
    _Pragma("unroll") for (int g_ = 0; g_ < 2; ++g_) _Pragma("unroll") for (int i = 0; i < 4; ++i) { \
      const h2 a2 = H2(Q[g_], i), q2 = H2(Q[2 + g_], i);                             \
      if (MODE == 0) {                      \
        S[4 * g_ + i] = S[4 * g_ + i] - a2 * (S[4 * g_ + i] - vv);                   \
        if (g_ == 0) o0 += S[4 * g_ + i] * q2; else o1 += S[4 * g_ + i] * q2;        \
      } else {                                                                       \
        if (dir) { if (g_ == 0) o0 += S[4 * g_ + i] * q2; else o1 += S[4 * g_ + i] * q2; } \
        S[4 * g_ + i] = g2 * S[4 * g_ + i] + a2 * vv;                                \
        if (!dir) { if (g_ == 0) o0 += S[4 * g_ + i] * q2; else o1 += S[4 * g_ + i] * q2; } \
      }                                                                              \
    }                                                                                \
    float o = ((float)o0.x + (float)o0.y) + ((float)o1.x + (float)o1.y);             \
    o += dpp_xor1(o); o += dpp_xor2(o);                                              \
    if (dp == 0) { int row = vrow(b, dir, ch * 8 + (S_)); O[(size_t)row * 256 + h * 64 + mycol] = f2bf(o); } }
  GLA_LOADRAW(0)
#pragma unroll 1
  for (int ch = 0; ch < 288; ++ch) {
#pragma unroll
    for (int s = 0; s < 8; ++s) {
      _Float16* q = (_Float16*)(sw + s * 128);
      q[lane] = (_Float16)bf2f(r0[s]); q[64 + lane] = (_Float16)bf2f(r1[s]);
      sw[s * 128 + 64 + lane] = bf2f(r2[s]);
    }
    wave_lds_sync();
    if (ch + 1 < 288) { GLA_LOADRAW(ch + 1) }
    SB();
    h8 QA[4], QB[4]; float vA, vB;
    GLA_LD(QA, vA, 0) SB();
    GLA_LD(QB, vB, 1) SB(); GLA_CMP(QA, vA, 0) SB();
    GLA_LD(QA, vA, 2) SB(); GLA_CMP(QB, vB, 1) SB();
    GLA_LD(QB, vB, 3) SB(); GLA_CMP(QA, vA, 2) SB();
    GLA_LD(QA, vA, 4) SB(); GLA_CMP(QB, vB, 3) SB();
    GLA_LD(QB, vB, 5) SB(); GLA_CMP(QA, vA, 4) SB();
    GLA_LD(QA, vA, 6) SB(); GLA_CMP(QB, vB, 5) SB();
    GLA_LD(QB, vB, 7) SB(); GLA_CMP(QA, vA, 6) SB();
    GLA_CMP(QB, vB, 7) SB();
    wave_lds_sync();
  }
  __builtin_amdgcn_s_setprio(0);
#undef GLA_LOADRAW
#undef GLA_LD
#undef GLA_CMP
}

DEVINL void scan_s5(const Params& p, int l, int b, int dir, int g, int lane, float* smC) {
  asm volatile("" : "+v"(lane));
  char* ws = p.ws;
  const bf16_t* PR = (const bf16_t*)(ws + OFF_AR + AR_PREST);
  bf16_t* O = (bf16_t*)(ws + OFF_AR + AR_OUT) + (size_t)(dir ? 7 : 8) * OUTSLOT;
  _Float16* hC = (_Float16*)smC;
  _Float16* hS = (_Float16*)(smC + 1024);
  float* smU = smC + 2048;
  const size_t gi = (size_t)((l * 2 + dir) * 16 + g);
  float lbr, lbi; h2 bb[16];
  {
    float lr = p.in[23][gi * 64 + lane], li = p.in[24][gi * 64 + lane];
    float dt = expf(p.in[25][gi]);
    float mag = expf(lr * dt);
    lbr = mag * cosf(li * dt); lbi = mag * sinf(li * dt);
    float den = lr * lr + li * li;
    float fre = ((lbr - 1.f) * lr + lbi * li) / den;
    float fim = (lbi * lr - (lbr - 1.f) * li) / den;
    const float* br = p.in[26] + (gi * 64 + lane) * 16;
    const float* bi = p.in[27] + (gi * 64 + lane) * 16;
#pragma unroll
    for (int i = 0; i < 16; ++i) {
      float r_ = br[i], i_ = bi[i];
      bb[i] = h2{(_Float16)(fre * r_ - fim * i_), (_Float16)(fre * i_ + fim * r_)};
    }
    const float* cr = p.in[28] + gi * 1024;
    const float* ci = p.in[29] + gi * 1024;
#pragma unroll
    for (int o = 0; o < 16; ++o) {
      hC[(o * 2 + 0) * 64 + lane] = (_Float16)cr[o * 64 + lane];
      hC[(o * 2 + 1) * 64 + lane] = (_Float16)ci[o * 64 + lane];
    }
  }
  float sre = 0.f, sim = 0.f;
  const int ts = lane >> 2, i4 = lane & 3;
  uint2 raw = *(const uint2*)(PR + (size_t)vrow(b, dir, ts) * PREST + 1024 + g * 16 + i4 * 4);
#pragma unroll 1
  for (int ch = 0; ch < 144; ++ch) {
    {
      h2 d0, d1, d2, d3;
      _Float16 u0 = (_Float16)bf2f((bf16_t)(raw.x & 0xffff)), u1 = (_Float16)bf2f((bf16_t)(raw.x >> 16));
      _Float16 u2 = (_Float16)bf2f((bf16_t)(raw.y & 0xffff)), u3 = (_Float16)bf2f((bf16_t)(raw.y >> 16));
      d0 = h2{u0, u0}; d1 = h2{u1, u1}; d2 = h2{u2, u2}; d3 = h2{u3, u3};
      h8 pk = h8{d0.x, d0.y, d1.x, d1.y, d2.x, d2.y, d3.x, d3.y};
      *(h8*)(smU + ts * 16 + i4 * 4) = pk;
    }
    wave_lds_sync();
    if (ch + 1 < 144) raw = *(const uint2*)(PR + (size_t)vrow(b, dir, (ch + 1) * 16 + ts) * PREST + 1024 + g * 16 + i4 * 4);
#pragma unroll 4
    for (int s = 0; s < 16; ++s) {
      const h8* u = (const h8*)(smU + s * 16);
      h8 u0 = u[0], u1 = u[1], u2 = u[2], u3 = u[3];
      h2 a0 = bb[0] * H2(u0, 0), a1 = bb[1] * H2(u0, 1);
      a0 += bb[2] * H2(u0, 2); a1 += bb[3] * H2(u0, 3);
      a0 += bb[4] * H2(u1, 0); a1 += bb[5] * H2(u1, 1);
      a0 += bb[6] * H2(u1, 2); a1 += bb[7] * H2(u1, 3);
      a0 += bb[8] * H2(u2, 0); a1 += bb[9] * H2(u2, 1);
      a0 += bb[10] * H2(u2, 2); a1 += bb[11] * H2(u2, 3);
      a0 += bb[12] * H2(u3, 0); a1 += bb[13] * H2(u3, 1);
      a0 += bb[14] * H2(u3, 2); a1 += bb[15] * H2(u3, 3);
      const float bur = (float)a0.x + (float)a1.x, bui = (float)a0.y + (float)a1.y;
      float nre = lbr * sre - lbi * sim + bur;
      float nim = lbr * sim + lbi * sre + bui;
      sre = nre; sim = nim;
      hS[(s * 2 + 0) * 64 + lane] = (_Float16)sre;
      hS[(s * 2 + 1) * 64 + lane] = (_Float16)sim;
    }
    wave_lds_sync();
    {
      h2 acc[4];
#pragma unroll
      for (int oo = 0; oo < 4; ++oo) acc[oo] = h2{(_Float16)0.f, (_Float16)0.f};
      const _Float16* sr = hS + (ts * 2 + 0) * 64;
      const _Float16* si = hS + (ts * 2 + 1) * 64;
#pragma unroll 4
      for (int p8 = 0; p8 < 8; ++p8) {
        h8 a = *(const h8*)(sr + p8 * 8), bq = *(const h8*)(si + p8 * 8);
#pragma unroll
        for (int oo = 0; oo < 4; ++oo) {
          int o = i4 * 4 + oo;
          h8 cr8 = *(const h8*)(hC + (o * 2 + 0) * 64 + p8 * 8);
          h8 ci8 = *(const h8*)(hC + (o * 2 + 1) * 64 + p8 * 8);
#pragma unroll
          for (int j = 0; j < 4; ++j) { acc[oo] += H2(cr8, j) * H2(a, j); acc[oo] -= H2(ci8, j) * H2(bq, j); }
        }
      }
      int row = vrow(b, dir, ch * 16 + ts);
      uint2 pk;
      pk.x = (unsigned)f2bf((float)acc[0].x + (float)acc[0].y) | ((unsigned)f2bf((float)acc[1].x + (float)acc[1].y) << 16);
      pk.y = (unsigned)f2bf((float)acc[2].x + (float)acc[2].y) | ((unsigned)f2bf((float)acc[3].x + (float)acc[3].y) << 16);
      *(uint2*)(O + (size_t)row * 256 + g * 16 + i4 * 4) = pk;
    }
    wave_lds_sync();
  }
}

DEVINL void phase_scans(const Params& p, int l, float* smf) {
  const int tid = otid(p.wave), lane = tid & 63, wid = __builtin_amdgcn_readfirstlane(tid >> 6);
  for (int task = blockIdx.x; task < 256; task += gridDim.x) {
    if (wid < 2) {
      const int chain = task >> 1, quarter = (task & 1) * 2 + wid;
      scan_rwkv(p, l, chain >> 3, (chain >> 2) & 1, chain & 3, quarter, lane, smf + wid * 1792);
    } else if (wid < 4) {
      const int t2 = task + (wid - 2) * 256;
      scan_s5(p, l, t2 >> 5, (t2 >> 4) & 1, t2 & 15, lane, smf + 9728 + (wid - 2) * 4352);
    } else {
      const int chain = task & 127, quarter = wid - 4;
      if (task < 128) scan_gla<0>(p, l, chain >> 3, (chain >> 2) & 1, chain & 3, quarter, lane, smf + 3584 + quarter * 1536);
      else scan_gla<1>(p, l, chain >> 3, (chain >> 2) & 1, chain & 3, quarter, lane, smf + 3584 + quarter * 1536);
    }
  }
}

DEVINL void phase_post(const Params& p, int l, bool skipctx = false) {
  char* ws = p.ws;
  bf16_t* OUTp = (bf16_t*)(ws + OFF_AR + AR_OUT);
  const bf16_t* PR = (const bf16_t*)(ws + OFF_AR + AR_PREST);
  const bf16_t* RKV = (const bf16_t*)(ws + OFF_AR + AR_RKV);
  const bf16_t* L = (const bf16_t*)(ws + OFF_AR + AR_L);
  const int lane = otid(p.wave) & 63, wid = otid(p.wave) >> 6;
  const int gw = blockIdx.x * 8 + wid, nw = gridDim.x * 8;
  const int c = lane * 4;
  const F4 gn_a = ld4f(p.in[21] + l * 256 + c), ka = ld4f(p.in[19] + l * 256 + c), rk = ld4f(p.in[20] + l * 256 + c);
  const F4 gn_b = ld4f(p.in[22] + l * 256 + c), dsk = ld4f(p.in[30] + l * 256 + c), gn_d = ld4f(p.in[35] + l * 256 + c);
  for (int row = gw; row < MROWS; row += nw) {
    if (skipctx && (row % SEQT) < 256) continue;
    const size_t ro = (size_t)row * 256 + c;
    {
      F4 y0 = ld4bf(OUTp + 0 * OUTSLOT + ro), y1 = ld4bf(OUTp + 4 * OUTSLOT + ro);
      float a0 = y0.a + y1.a, a1 = y0.b + y1.b, a2 = y0.c + y1.c, a3 = y0.d + y1.d;
      float mean = row16_sum(a0 + a1 + a2 + a3) * (1.f / 64.f);
      a0 -= mean; a1 -= mean; a2 -= mean; a3 -= mean;
      float rs = rsqrtf(row16_sum(a0 * a0 + a1 * a1 + a2 * a2 + a3 * a3) * (1.f / 64.f) + 64e-5f);
      F4 r_ = ld4bf(RKV + (size_t)row * 1024 + c), k_ = ld4bf(RKV + (size_t)row * 1024 + 256 + c), v_ = ld4bf(RKV + (size_t)row * 1024 + 512 + c);
      F4 af = ld4bf(L + (size_t)row * 1280 + 512 + c), ab = ld4bf(L + (size_t)row * 1280 + 768 + c), gg = ld4bf(L + (size_t)row * 1280 + 1024 + c);
      float t = r_.a * k_.a * rk.a * (2.f + (af.a + ab.a - 2.f) * ka.a) + r_.b * k_.b * rk.b * (2.f + (af.b + ab.b - 2.f) * ka.b)
              + r_.c * k_.c * rk.c * (2.f + (af.c + ab.c - 2.f) * ka.c) + r_.d * k_.d * rk.d * (2.f + (af.d + ab.d - 2.f) * ka.d);
      float bs = row16_sum(t);
      st4bf(OUTp + 0 * OUTSLOT + ro, (a0 * rs * gn_a.a + bs * v_.a) * gg.a, (a1 * rs * gn_a.b + bs * v_.b) * gg.b,
            (a2 * rs * gn_a.c + bs * v_.c) * gg.c, (a3 * rs * gn_a.d + bs * v_.d) * gg.d);
    }
    {
      F4 y0 = ld4bf(OUTp + 1 * OUTSLOT + ro), y1 = ld4bf(OUTp + 5 * OUTSLOT + ro);
      float a0 = y0.a + y1.a, a1 = y0.b + y1.b, a2 = y0.c + y1.c, a3 = y0.d + y1.d;
      float mean = row16_sum(a0 + a1 + a2 + a3) * (1.f / 64.f);
      a0 -= mean; a1 -= mean; a2 -= mean; a3 -= mean;
      float rs = rsqrtf(row16_sum(a0 * a0 + a1 * a1 + a2 * a2 + a3 * a3) * (1.f / 64.f) + 1e-5f);
      F4 g = ld4bf(PR + (size_t)row * PREST + 768 + c);
      st4bf(OUTp + 1 * OUTSLOT + ro, a0 * rs * gn_b.a * silu(g.a), a1 * rs * gn_b.b * silu(g.b), a2 * rs * gn_b.c * silu(g.c), a3 * rs * gn_b.d * silu(g.d));
    }
    {
      F4 u = ld4bf(PR + (size_t)row * PREST + 1024 + c);
      F4 y0 = ld4bf(OUTp + 8 * OUTSLOT + ro), y1 = ld4bf(OUTp + 7 * OUTSLOT + ro);
      float e0 = dsk.a * u.a + y0.a + y1.a, e1 = dsk.b * u.b + y0.b + y1.b, e2 = dsk.c * u.c + y0.c + y1.c, e3 = dsk.d * u.d + y0.d + y1.d;
      e0 = 0.5f * e0 * (1.f + tanh_fast(0.7978845608028654f * (e0 + 0.044715f * e0 * e0 * e0)));
      e1 = 0.5f * e1 * (1.f + tanh_fast(0.7978845608028654f * (e1 + 0.044715f * e1 * e1 * e1)));
      e2 = 0.5f * e2 * (1.f + tanh_fast(0.7978845608028654f * (e2 + 0.044715f * e2 * e2 * e2)));
      e3 = 0.5f * e3 * (1.f + tanh_fast(0.7978845608028654f * (e3 + 0.044715f * e3 * e3 * e3)));
      st4bf(OUTp + 8 * OUTSLOT + ro, e0, e1, e2, e3);
    }
    {
      F4 y0 = ld4bf(OUTp + 3 * OUTSLOT + ro), y1 = ld4bf(OUTp + 6 * OUTSLOT + ro);
      float a0 = y0.a + y1.a, a1 = y0.b + y1.b, a2 = y0.c + y1.c, a3 = y0.d + y1.d;
      float rs = rsqrtf(row16_sum(a0 * a0 + a1 * a1 + a2 * a2 + a3 * a3) * (1.f / 64.f) + 1e-5f);
      F4 g = ld4bf(PR + (size_t)row * PREST + 2304 + c);
      st4bf(OUTp + 3 * OUTSLOT + ro, a0 * rs * gn_d.a * silu(g.a), a1 * rs * gn_d.b * silu(g.b), a2 * rs * gn_d.c * silu(g.c), a3 * rs * gn_d.d * silu(g.d));
    }
  }
}

__global__ void __launch_bounds__(512, 2) mega(Params p_in) {
  Params p = p_in;
  p.wave = __builtin_amdgcn_readfirstlane((int)threadIdx.x >> 6);
  cg::grid_group grid = cg::this_grid();
  extern __shared__ __attribute__((aligned(16))) unsigned char smem[];
  float* smf = (float*)smem;
  char* ws = p.ws;

  if (p.ws_size < WS_NEED) {
    for (size_t i = (size_t)blockIdx.x * 512 + otid(p.wave); i < (size_t)NB * 2048 * 1024; i += (size_t)gridDim.x * 512)
      p.out[i] = __uint_as_float(0x7fc00000u);
    return;
  }

  unsigned* barw = (unsigned*)(ws + OFF_BAR);
  volatile XLAS unsigned* xst = (volatile XLAS unsigned*)(XLAS unsigned char*)(smem + 131072);
  if (blockIdx.x == 0) for (int i = otid(p.wave); i < XCD_BAR_WORDS; i += 512) barw[i] = 0u;
  if (otid(p.wave) < 4) xst[otid(p.wave)] = 0u;
  phase_ada_partial(p, smf);
  phase_tables(p);
  grid.sync();
  (void)xcd_barrier_post(p.wave, barw, xst);
  phase_ada_reduce(p);
  xcd_barrier(p, smem);

  float* X = (float*)(ws + OFF_X);
  const float* Mod = (const float*)(ws + OFF_MOD);
  bf16_t* HFFN = (bf16_t*)(ws + OFF_AR + AR_HFFN);
  bf16_t* HMIX = (bf16_t*)(ws + OFF_AR + AR_HMIX);
  bf16_t* HP = (bf16_t*)(ws + OFF_AR + AR_HP);
  bf16_t* U = (bf16_t*)(ws + OFF_AR + AR_U);
  bf16_t* OUTp = (bf16_t*)(ws + OFF_AR + AR_OUT);
  bf16_t* BR = (bf16_t*)(ws + OFF_AR + AR_BR);

  for (int l = 0; l < DEPTH; ++l) {
    if (l == 0) phase_lnmod(p, true, false, 0, 0, 0, 0, HFFN, false);
    else phase_lnmod(p, false, true, l - 1, 2, l, 0, HFFN, false);
    const int idle0 = (576 % (int)gridDim.x);
    if (l == 0) { conv_ffn(p, 0, 0, smf); }
    else conv_ffn(p, l, 0, smf, 1408, 2112);
    xcd_barrier(p, smem);
    run_gemm(p.wave, smem, HFFN, (const bf16_t*)(ws + OFF_W13), MROWS, 5632, 1024, EpiSwiglu{U});
    xcd_barrier(p, smem);
    run_gemm(p.wave, smem, U, (const bf16_t*)(ws + OFF_W2), MROWS, 1024, FF, EpiResid{X, Mod, l, 2, 0.5f});
    conv_mix(p, l, smf, idle0);
    xcd_barrier(p, smem);
    phase_lnmod(p, false, true, l, 0, l, 3, HMIX, false);
    xcd_barrier(p, smem);
    run_gemm(p.wave, smem, HMIX, (const bf16_t*)(ws + OFF_WIN), MROWS, 3840, 1024,
             EpiPin{(bf16_t*)(ws + OFF_AR + AR_PRW), (bf16_t*)(ws + OFF_AR + AR_PREST)});
    xcd_barrier(p, smem);
    phase_shift(p, l);
    xcd_barrier(p, smem);
    run_gemm(p.wave, smem, (const bf16_t*)(ws + OFF_AR + AR_A2), (const bf16_t*)(ws + OFF_WL), MROWS, 1280, 384,
             EpiLora{(bf16_t*)(ws + OFF_AR + AR_L), p.in[13] + l * 512, p.in[15] + l * 512});
    xcd_barrier(p, smem);
    phase_scans(p, l, smf);
    xcd_barrier(p, smem);
    const int last = (l == DEPTH - 1);
    phase_post(p, l, last);
    xcd_barrier(p, smem);
    run_gemm(p.wave, smem, OUTp + 8 * OUTSLOT, (const bf16_t*)(ws + OFF_WGLU), MROWS, 256, 256,
             EpiGlu{OUTp + 8 * OUTSLOT, OUTp + 2 * OUTSLOT, p.in[32] + l * 256}, last);
    phase_lnmod(p, false, false, 0, 0, l, 3, HP, false, last);
    xcd_barrier(p, smem);
    run_gemm<EpiBranch, pg8::BranchOrder>(p.wave, smem, OUTp, (const bf16_t*)(ws + OFF_WB), 4 * MROWS, 1024, 256, EpiBranch{BR}, last);
    run_gemm<EpiGate, pg8::GateOrder>(p.wave, smem, HP, (const bf16_t*)(ws + OFF_WG), 4 * MROWS, 1024, 1024, EpiGate{BR, p.in[38] + (size_t)l * 4096}, last);
    xcd_barrier(p, smem);
    run_gemm(p.wave, smem, BR, (const bf16_t*)(ws + OFF_WO4), MROWS, 1024, 4096, EpiResid{X, Mod, l, 5, 1.0f}, last);
    conv_ffn(p, l, 1, smf, 0, 2112, last ? 0 : idle0);
    xcd_barrier(p, smem);
    phase_lnmod(p, false, true, l, 1, l, 6, HFFN, false, last);
    xcd_barrier(p, smem);
    run_gemm(p.wave, smem, HFFN, (const bf16_t*)(ws + OFF_W13), MROWS, 5632, 1024, EpiSwiglu{U}, last);
    xcd_barrier(p, smem);
    run_gemm(p.wave, smem, U, (const bf16_t*)(ws + OFF_W2), MROWS, 1024, FF, EpiResid{X, Mod, l, 8, 0.5f}, last);
    if (l + 1 < DEPTH) conv_ffn(p, l + 1, 0, smf, 0, 1408, idle0);
    xcd_barrier(p, smem);
  }
  phase_lnmod(p, false, true, DEPTH - 1, 2, 0, 0, HFFN, true, true);
}

extern "C" void kernel_launch(void* const* d_in, const int* in_sizes, int n_in, void* d_out, int out_size,
                              void* d_ws, size_t ws_size, hipStream_t stream) {
  static int grid_blocks = 0;
  if (!grid_blocks) {
    int dev = 0, cus = 0, per_cu = 0;
    (void)hipGetDevice(&dev);
    (void)hipDeviceGetAttribute(&cus, hipDeviceAttributeMultiprocessorCount, dev);
    (void)hipFuncSetAttribute((const void*)mega, hipFuncAttributeMaxDynamicSharedMemorySize, LDS_BYTES);
    (void)hipOccupancyMaxActiveBlocksPerMultiprocessor(&per_cu, mega, 512, LDS_BYTES);
    if (per_cu > 1) per_cu = 1;
    if (per_cu < 1) per_cu = 1;
    grid_blocks = cus * per_cu;
  }
  Params p{};
  for (int i = 0; i < 40; ++i) p.in[i] = (const float*)d_in[i];
  p.out = (float*)d_out;
  p.ws = (char*)d_ws;
  p.ws_size = (unsigned long long)ws_size;
  void* args[] = {&p};
  hipError_t e = hipLaunchCooperativeKernel((void*)mega, dim3(grid_blocks), dim3(512), args, LDS_BYTES, stream);
  if (e != hipSuccess) fprintf(stderr, "cooperative launch failed: %s (grid %d)\n", hipGetErrorString(e), grid_blocks);
}
```

```cpp
#include <hip/hip_runtime.h>
#include <hip/hip_cooperative_groups.h>
#include <cstdio>
#include <cstdint>
namespace cg = cooperative_groups;

typedef unsigned short bf16_t;
using bf16x8 = __attribute__((ext_vector_type(8))) short;
using f32x4 = __attribute__((ext_vector_type(4))) float;

#define DEVINL __device__ __forceinline__

constexpr int NB = 16, SEQT = 2304, MROWS = NB * SEQT;
constexpr int D = 1024, FF = 2816, DEPTH = 4;
constexpr int PRW = 1056, PREST = 2560;
constexpr float ALPHA = 1.681792830507429f;
constexpr int LDS_BYTES = 131072 + 256;

constexpr size_t OFF_X = 0;
constexpr size_t OFF_MOD = OFF_X + (size_t)MROWS * 1024 * 4;
constexpr size_t OFF_TAB = OFF_MOD + (size_t)4 * 17 * 9216 * 4;
constexpr size_t OFF_W13 = OFF_TAB + 12288;
constexpr size_t OFF_W2 = OFF_W13 + (size_t)5632 * 1024 * 2;
constexpr size_t OFF_WIN = OFF_W2 + (size_t)1024 * 2816 * 2;
constexpr size_t OFF_WG = OFF_WIN + (size_t)3840 * 1024 * 2;
constexpr size_t OFF_WB = OFF_WG + (size_t)4096 * 1024 * 2;
constexpr size_t OFF_WO4 = OFF_WB + (size_t)4096 * 256 * 2;
constexpr size_t OFF_WL = OFF_WO4 + (size_t)1024 * 4096 * 2;
constexpr size_t OFF_WGLU = OFF_WL + (size_t)1280 * 384 * 2;
constexpr size_t OFF_BAR = OFF_WGLU + (size_t)256 * 256 * 2;
constexpr size_t OFF_AR = OFF_BAR + 16384;
constexpr size_t AR_PREST = 0;
constexpr size_t AR_L = AR_PREST + (size_t)MROWS * PREST * 2;
constexpr size_t AR_RKV = AR_L + (size_t)MROWS * 1280 * 2;
constexpr size_t AR_OUT = AR_RKV + (size_t)MROWS * 1024 * 2;
constexpr size_t AR_END = AR_OUT + (size_t)9 * MROWS * 256 * 2;
constexpr size_t AR_PRW = AR_OUT;
constexpr size_t AR_A2 = AR_OUT + (size_t)MROWS * PRW * 2;
constexpr size_t AR_HFFN = 0;
constexpr size_t AR_U = (size_t)MROWS * 1024 * 2;
constexpr size_t AR_HMIX = AR_L;
constexpr size_t AR_BR = 0;
constexpr size_t AR_MODP = 0;
constexpr size_t WS_NEED = OFF_AR + AR_END;
constexpr size_t OUTSLOT = (size_t)MROWS * 256;
constexpr size_t AR_HP = AR_OUT + 4 * OUTSLOT * 2;
static_assert((size_t)MROWS * 4096 * 2 <= AR_OUT, "Br must not reach the OUT slots");

struct Params {
  const float* in[40];
  float* out;
  char* ws;
  unsigned long long ws_size;
  int wave;
  int pad_;
};

DEVINL int otid(int wave) { int ln; asm volatile("v_mbcnt_lo_u32_b32 %0, -1, 0\n\tv_mbcnt_hi_u32_b32 %0, -1, %0" : "=v"(ln)); return wave * 64 + ln; }
DEVINL bf16_t f2bf(float f) {
  unsigned u = __float_as_uint(f);
  u += 0x7fffu + ((u >> 16) & 1u);
  return (bf16_t)(u >> 16);
}
DEVINL float bf2f(bf16_t h) { return __uint_as_float(((unsigned)h) << 16); }
typedef __bf16 bf16x2_t __attribute__((ext_vector_type(2)));
DEVINL unsigned pk2(float a, float b) { bf16x2_t v = {(__bf16)a, (__bf16)b}; return __builtin_bit_cast(unsigned, v); }
DEVINL float sigm(float x) { return __builtin_amdgcn_rcpf(1.f + __expf(-x)); }
DEVINL float silu(float x) { return x * __builtin_amdgcn_rcpf(1.f + __expf(-x)); }
DEVINL float tanh_fast(float x) { return 1.f - 2.f * __builtin_amdgcn_rcpf(1.f + __expf(2.f * x)); }
DEVINL float wave_sum(float v) {
#pragma unroll
  for (int o = 32; o > 0; o >>= 1) v += __shfl_xor(v, o);
  return v;
}

DEVINL void conv_tile(int wave, bool valid, const float* __restrict__ src, int ldsrc, int k0, int kval, int n0, int nval,
                      bf16_t* dst, int ldd, int dk0, int mode, int which, int drow0, float* sm) {
  const int tid = otid(wave) & 255;
#pragma unroll
  for (int i = 0; i < 16; ++i) {
    int k = i * 4 + (tid >> 6), n = tid & 63;
    float v = 0.f;
    if (valid && src != nullptr && (k0 + k) < kval && (n0 + n) < nval) v = src[(size_t)(k0 + k) * ldsrc + n0 + n];
    sm[k * 65 + n] = v;
  }
  __syncthreads();
  if (valid) {
#pragma unroll
    for (int i = 0; i < 8; ++i) {
      int j = i * 8 + (tid >> 5), kp = tid & 31;
      int n = n0 + j;
      int drow = (mode == 1) ? ((n >> 4) * 32 + which * 16 + (n & 15)) : (drow0 + j);
      unsigned lo = f2bf(sm[(2 * kp) * 65 + j]), hi = f2bf(sm[(2 * kp + 1) * 65 + j]);
      *(unsigned*)(dst + (size_t)drow * ldd + dk0 + 2 * kp) = lo | (hi << 16);
    }
  }
  __syncthreads();
}

DEVINL void conv_ffn(const Params& p, int l, int i, float* smf, int t_lo = 0, int t_hi = 2112, int blk0 = 0) {
  char* ws = p.ws;
  bf16_t* W13 = (bf16_t*)(ws + OFF_W13);
  bf16_t* W2 = (bf16_t*)(ws + OFF_W2);
  const float* w1 = p.in[8] + (size_t)(l * 2 + i) * 1024 * 2816;
  const float* w3 = p.in[9] + (size_t)(l * 2 + i) * 1024 * 2816;
  const float* w2 = p.in[10] + (size_t)(l * 2 + i) * 2816 * 1024;
  const int half = otid(p.wave) >> 8;
  float* sm = smf + half * 4160;
  if ((int)blockIdx.x < blk0) return;
  for (int t0 = t_lo + ((int)blockIdx.x - blk0) * 2; t0 < t_hi; t0 += ((int)gridDim.x - blk0) * 2) {
    int t = t0 + half; bool valid = t < t_hi; if (!valid) t = t_hi - 1;
    if (t < 1408) {
      int which = t >= 704; int tt = t - which * 704;
      int nt_ = tt % 44, kt = tt / 44;
      conv_tile(p.wave, valid, which ? w3 : w1, 2816, kt * 64, 1024, nt_ * 64, 2816, W13, 1024, kt * 64, 1, which, 0, sm);
    } else {
      int tt = t - 1408; int nt_ = tt % 16, kt = tt / 16;
      conv_tile(p.wave, valid, w2, 1024, kt * 64, 2816, nt_ * 64, 1024, W2, 2816, kt * 64, 0, 0, nt_ * 64, sm);
    }
  }
}

DEVINL void conv_mix(const Params& p, int l, float* smf, int blk0 = 0) {
  char* ws = p.ws;
  const int half = otid(p.wave) >> 8;
  float* sm = smf + half * 4160;
  const int T = 3400;
  if ((int)blockIdx.x < blk0) return;
  for (int t0 = ((int)blockIdx.x - blk0) * 2; t0 < T; t0 += ((int)gridDim.x - blk0) * 2) {
    int t = t0 + half; bool valid = t < T; if (!valid) t = T - 1;
    if (t < 960) {
      int nt_ = t % 60, kt = t / 60;
      conv_tile(p.wave, valid, p.in[11] + (size_t)l * 1024 * 3616, 3616, kt * 64, 1024, nt_ * 64, 3616,
                (bf16_t*)(ws + OFF_WIN), 1024, kt * 64, 0, 0, nt_ * 64, sm);
    } else if (t < 1984) {
      int tt = t - 960; int nt_ = tt % 64, kt = tt / 64;
      conv_tile(p.wave, valid, p.in[37] + (size_t)l * 1024 * 4096, 4096, kt * 64, 1024, nt_ * 64, 4096,
                (bf16_t*)(ws + OFF_WG), 1024, kt * 64, 0, 0, nt_ * 64, sm);
    } else if (t < 2240) {
      int tt = t - 1984; int n = tt >> 6; int r = tt & 63; int nt_ = r % 16, kt = r / 16;
      conv_tile(p.wave, valid, p.in[36] + (size_t)(l * 4 + n) * 256 * 1024, 1024, kt * 64, 256, nt_ * 64, 1024,
                (bf16_t*)(ws + OFF_WB) + (size_t)n * 1024 * 256, 256, kt * 64, 0, 0, nt_ * 64, sm);
    } else if (t < 3264) {
      int tt = t - 2240; int rep = tt >> 8; int r = tt & 255; int nt_ = r % 16, kt = r / 16;
      conv_tile(p.wave, valid, p.in[39] + (size_t)l * 1024 * 1024, 1024, kt * 64, 1024, nt_ * 64, 1024,
                (bf16_t*)(ws + OFF_WO4), 4096, rep * 1024 + kt * 64, 0, 0, nt_ * 64, sm);
    } else if (t < 3280) {
      int tt = t - 3264; int nt_ = tt % 4, kt = tt / 4;
      conv_tile(p.wave, valid, p.in[31] + (size_t)l * 256 * 256, 256, kt * 64, 256, nt_ * 64, 256,
                (bf16_t*)(ws + OFF_WGLU), 256, kt * 64, 0, 0, nt_ * 64, sm);
    } else {
      int tt = t - 3280; int nt_ = tt % 20, kt = tt / 20;
      int seg = nt_ >> 2, sub = nt_ & 3;
      const float* s_ = nullptr; int k0 = 0, kval = 0;
      if (seg == 0 && kt == 0) { s_ = p.in[14] + (size_t)(l * 2 + 0) * 64 * 256; kval = 64; }
      else if (seg == 1 && kt == 0) { s_ = p.in[14] + (size_t)(l * 2 + 1) * 64 * 256; kval = 64; }
      else if (seg == 2 && kt == 1) { s_ = p.in[16] + (size_t)(l * 2 + 0) * 64 * 256; kval = 64; }
      else if (seg == 3 && kt == 1) { s_ = p.in[16] + (size_t)(l * 2 + 1) * 64 * 256; kval = 64; }
      else if (seg == 4 && kt >= 2 && kt <= 4) { s_ = p.in[17] + (size_t)l * 160 * 256; k0 = (kt - 2) * 64; kval = 160; }
      conv_tile(p.wave, valid, s_, 256, k0, kval, sub * 64, 256, (bf16_t*)(ws + OFF_WL), 384, kt * 64, 0, 0, nt_ * 64, sm);
    }
  }
}

namespace pg8 {
#define PG8_LAS __attribute__((address_space(3)))
constexpr int BM = 256, BK = 64, HALF = 128, HTB = HALF * BK * 2, STAGE_BYTES = 8 * HTB, NXCD = 8, WGM = 4;
DEVINL int lds_byte(int r, int c) { const int st = (r >> 4) * 2 + (c >> 5), rr = r & 15, cc = c & 31, ob = rr * 64 + cc * 2; return st * 1024 + (ob ^ (((ob >> 9) & 1) << 5)); }
DEVINL void stage_rc(int b, int& R, int& C) { const int st = b / 1024, sb = b % 1024, swz = sb ^ (((sb >> 9) & 1) << 5); R = (st >> 1) * 16 + swz / 64; C = (st & 1) * 32 + (swz % 64) / 2; }
struct Unit { int pm, pn; };
struct Gemm { const bf16_t* A; const bf16_t* Bt; int M, N, K; };
struct StaticOrder {
    int nM, nN, nwg, G, c, skip;
    DEVINL void init(int M, int N, int G_, int c_, int skip_) { nM = M / BM; if (skip_) nM = (nM / 9) * 8; nN = N / BM; nwg = nM * nN; G = G_; c = c_; skip = skip_; }
    DEVINL bool next(int i, Unit& u) const {
        const long Lx = (long)i * G + c; if (Lx >= nwg) return false;
        int wgid = (int)Lx; { const int q = nwg / NXCD, r = nwg % NXCD, xcd = wgid % NXCD, off = wgid / NXCD; wgid = (xcd < r ? xcd * (q + 1) : r * (q + 1) + (xcd - r) * q) + off; }
        const int nig = WGM * nN, gid = wgid / nig, fm = gid * WGM, gsz = (nM - fm) < WGM ? (nM - fm) : WGM;
        u.pm = fm + ((wgid % nig) % gsz); u.pn = (wgid % nig) / gsz;
        if (skip) u.pm = (u.pm >> 3) * 9 + 1 + (u.pm & 7);
        return true;
    }
    DEVINL void a_ready(const Unit&) const {}
    DEVINL void done(const Unit&) const {}
};
struct BranchOrder : StaticOrder {
    DEVINL bool next(int i, Unit& u) const { if (!StaticOrder::next(i, u)) return false; u.pn = (u.pm / 144) * 4 + u.pn; return true; }
};

template <class Epi, class Sched>
DEVINL void gemm_phase(int wave, PG8_LAS unsigned char* lds, const Gemm g, const Sched& S, const Epi& E) {
    const int tid = otid(wave), wid = __builtin_amdgcn_readfirstlane(tid >> 6), lane = tid & 63, wr = wid >> 2, wc = wid & 3, fr = lane & 15, fq = lane >> 4;
    const int K = g.K, nt = K / BK;
    unsigned voffA[2], voffB[2];
#pragma unroll
    for (int i = 0; i < 2; ++i) { int R, C; stage_rc(tid * 16 + i * 8192, R, C);
        voffA[i] = (unsigned)(R * K + C) * 2u; voffB[i] = (unsigned)(R * K + C) * 2u; }
    const size_t kstep = (size_t)(BK * 2);
    const size_t hstep = (size_t)HALF * K * 2;
    const size_t tstep = 2 * hstep;
    const unsigned ldsw = (unsigned)wid * 1024u;
    const int aoff = lds_byte(wr * 64 + fr, fq * 8), boff = lds_byte(wc * 32 + fr, fq * 8);
#define PG8_SA(b, h) (((b) * 2 + (h)) * HTB)
#define PG8_SB(b, h) ((4 + (b) * 2 + (h)) * HTB)
#define PG8_STAGE(bufoff, gbase, voff) do { _Pragma("unroll") for (int _i = 0; _i < 2; ++_i) \
        __builtin_amdgcn_global_load_lds((const unsigned*)((const char*)(gbase) + (voff)[_i]), (PG8_LAS unsigned*)(lds + (bufoff) + ldsw + _i * 8192), 16, 0, 0); } while (0)
#define PG8_LDA(dst, b, h) do { _Pragma("unroll") for (int m = 0; m < 4; ++m) _Pragma("unroll") for (int k = 0; k < 2; ++k) dst[m][k] = *(const PG8_LAS bf16x8*)(lds + PG8_SA(b, h) + aoff + m * 2048 + k * 1024); } while (0)
#define PG8_LDB(dst, b, h) do { _Pragma("unroll") for (int n = 0; n < 2; ++n) _Pragma("unroll") for (int k = 0; k < 2; ++k) dst[n][k] = *(const PG8_LAS bf16x8*)(lds + PG8_SB(b, h) + boff + n * 2048 + k * 1024); } while (0)
#define PG8_MMA(ai, bj, At, Bt) do { __builtin_amdgcn_s_setprio(1); _Pragma("unroll") for (int m = 0; m < 4; ++m) _Pragma("unroll") for (int n = 0; n < 2; ++n) _Pragma("unroll") for (int k = 0; k < 2; ++k) \
        acc[ai][bj][m][n] = __builtin_amdgcn_mfma_f32_16x16x32_bf16(Bt[n][k], At[m][k], acc[ai][bj][m][n], 0, 0, 0); __builtin_amdgcn_s_setprio(0); } while (0)
#define PG8_WAIT_V(n) asm volatile("s_waitcnt vmcnt(" #n ")" ::: "memory")
#define PG8_WAIT_L(n) asm volatile("s_waitcnt lgkmcnt(" #n ")" ::: "memory")
#define PG8_BAR __builtin_amdgcn_s_barrier()
#define PG8_SCHED __builtin_amdgcn_sched_barrier(0)
    Unit cur, nxt; int ui = 0;
    if (!S.next(0, cur)) return;
    f32x4 acc[2][2][4][2];
#pragma unroll
    for (int a = 0; a < 2; ++a)
#pragma unroll
        for (int b = 0; b < 2; ++b)
#pragma unroll
            for (int m = 0; m < 4; ++m)
#pragma unroll
                for (int n = 0; n < 2; ++n) acc[a][b][m][n] = (f32x4){0.f, 0.f, 0.f, 0.f};
    bf16x8 At[4][2], B0[2][2], B1[2][2];
    const char* cA = (const char*)g.A + (size_t)cur.pm * tstep; const char* cB = (const char*)g.Bt + (size_t)cur.pn * tstep;
    S.a_ready(cur);
    PG8_STAGE(PG8_SB(0, 0), cB, voffB); PG8_STAGE(PG8_SA(0, 0), cA, voffA); PG8_STAGE(PG8_SB(0, 1), cB + hstep, voffB); PG8_STAGE(PG8_SA(0, 1), cA + hstep, voffA);
    if (wr == 1) PG8_BAR;
    PG8_WAIT_V(4); PG8_BAR;
    PG8_STAGE(PG8_SB(1, 0), cB + kstep, voffB); PG8_STAGE(PG8_SA(1, 0), cA + kstep, voffA); PG8_STAGE(PG8_SB(1, 1), cB + hstep + kstep, voffB);
    PG8_WAIT_V(6); PG8_BAR;
    for (;;) {
        const bool has_next = S.next(ui + 1, nxt);
        const char* nA = has_next ? (const char*)g.A + (size_t)nxt.pm * tstep : cA; const char* nB = has_next ? (const char*)g.Bt + (size_t)nxt.pn * tstep : cB;
        for (int t = 0; t < nt; t += 2) {
            const bool last = (t == nt - 2);
            const char* a1 = cA + (size_t)(t + 1) * kstep;
            const char* a2 = last ? nA : cA + (size_t)(t + 2) * kstep; const char* b2 = last ? nB : cB + (size_t)(t + 2) * kstep;
            const char* a3 = a2 + kstep; const char* b3 = b2 + kstep;
            if (last && has_next) S.a_ready(nxt);
            PG8_LDB(B0, 0, 0); PG8_SCHED; PG8_LDA(At, 0, 0); PG8_STAGE(PG8_SA(1, 1), a1 + hstep, voffA);
            PG8_WAIT_L(8); PG8_BAR; PG8_WAIT_L(0); PG8_MMA(0, 0, At, B0); PG8_BAR; PG8_SCHED;
            PG8_LDB(B1, 0, 1); PG8_STAGE(PG8_SB(0, 0), b2, voffB);
            PG8_BAR; PG8_WAIT_L(0); PG8_MMA(0, 1, At, B1); PG8_BAR;
            PG8_LDA(At, 0, 1); PG8_STAGE(PG8_SA(0, 0), a2, voffA);
            PG8_BAR; PG8_WAIT_L(0); PG8_MMA(1, 0, At, B0); PG8_BAR; PG8_SCHED;
            PG8_STAGE(PG8_SB(0, 1), b2 + hstep, voffB);
            PG8_WAIT_V(6); PG8_BAR; PG8_MMA(1, 1, At, B1); PG8_BAR;
            PG8_LDB(B0, 1, 0); PG8_SCHED; PG8_LDA(At, 1, 0); PG8_STAGE(PG8_SA(0, 1), a2 + hstep, voffA);
            PG8_WAIT_L(8); PG8_BAR; PG8_WAIT_L(0); PG8_MMA(0, 0, At, B0); PG8_BAR; PG8_SCHED;
            PG8_LDB(B1, 1, 1); PG8_STAGE(PG8_SB(1, 0), b3, voffB);
            PG8_BAR; PG8_WAIT_L(0); PG8_MMA(0, 1, At, B1); PG8_BAR;
            PG8_LDA(At, 1, 1); PG8_STAGE(PG8_SA(1, 0), a3, voffA);
            PG8_BAR; PG8_WAIT_L(0); PG8_MMA(1, 0, At, B0); PG8_BAR; PG8_SCHED;
            PG8_STAGE(PG8_SB(1, 1), b3 + hstep, voffB);
            PG8_WAIT_V(6); PG8_BAR; PG8_MMA(1, 1, At, B1); PG8_BAR;
        }
        E(acc, cur, wr, wc, fr, fq); S.done(cur);
        if (!has_next) break;
#pragma unroll
        for (int a = 0; a < 2; ++a)
#pragma unroll
            for (int b = 0; b < 2; ++b)
#pragma unroll
                for (int m = 0; m < 4; ++m)
#pragma unroll
                    for (int n = 0; n < 2; ++n) acc[a][b][m][n] = (f32x4){0.f, 0.f, 0.f, 0.f};
        cur = nxt; cA = nA; cB = nB; ++ui;
    }
    PG8_WAIT_V(0);
    if (wr == 0) PG8_BAR;
    PG8_BAR;
#undef PG8_SA
#undef PG8_SB
#undef PG8_STAGE
#undef PG8_LDA
#undef PG8_LDB
#undef PG8_MMA
#undef PG8_WAIT_V
#undef PG8_WAIT_L
#undef PG8_BAR
#undef PG8_SCHED
}
}

using AccT = f32x4[2][2][4][2];
#define EPI_ROWS_BEGIN                                                                     \
  _Pragma("unroll") for (int ai = 0; ai < 2; ++ai) _Pragma("unroll") for (int m = 0; m < 4; ++m) { \
    const int row = rowbase + ai * 128 + m * 16;
#define EPI_ROWS_END }

#define EPI_RLOOP _Pragma("unroll") for (int ai = 0; ai < 2; ++ai) _Pragma("unroll") for (int m = 0; m < 4; ++m)
#define EPI_CLOOP _Pragma("unroll") for (int bj = 0; bj < 2; ++bj) _Pragma("unroll") for (int n = 0; n < 2; ++n)
struct EpiSwiglu {
  static constexpr bool PERM = false, AFTER_DRAIN = false;
  bf16_t* U;
  DEVINL void operator()(const AccT& acc, const pg8::Unit& u, int wr, int wc, int fr, int fq) const {
    const int rowbase = u.pm * 256 + wr * 64 + fr;
#pragma unroll
    for (int bj = 0; bj < 2; ++bj) {
      const int ucol = ((u.pn * 256 + bj * 128 + wc * 32) >> 5) * 16 + 4 * fq;
      EPI_RLOOP {
        const int row = rowbase + ai * 128 + m * 16;
        f32x4 a = acc[ai][bj][m][0], b = acc[ai][bj][m][1];
        uint2 pk; pk.x = pk2(silu(a[0]) * b[0], silu(a[1]) * b[1]); pk.y = pk2(silu(a[2]) * b[2], silu(a[3]) * b[3]);
        *(uint2*)(U + (size_t)row * FF + ucol) = pk;
      }
    }
  }
};
struct EpiResid {
  static constexpr bool PERM = false, AFTER_DRAIN = false;
  float* X; const float* Mod; int ml, mj; float gs;
  DEVINL void operator()(const AccT& acc, const pg8::Unit& u, int wr, int wc, int fr, int fq) const {
    const int rowbase = u.pm * 256 + wr * 64 + fr;
    const int bq = u.pm / 9, mr = (u.pm - bq * 9 == 0) ? 16 : bq;
    const float* gv = Mod + (size_t)(ml * 17 + mr) * 9216 + mj * 1024;
    EPI_CLOOP {
      const int col = u.pn * 256 + bj * 128 + wc * 32 + n * 16 + 4 * fq;
      const f32x4 g4 = *(const f32x4*)(gv + col) * gs;
      EPI_RLOOP {
        const int row = rowbase + ai * 128 + m * 16;
        float* xp = X + (size_t)row * 1024 + col;
        f32x4 x = *(const f32x4*)xp;
        *(f32x4*)xp = x * ALPHA + g4 * acc[ai][bj][m][n];
        if (m & 1) __builtin_amdgcn_sched_barrier(0);
      }
    }
  }
};
struct EpiPin {
  static constexpr bool PERM = false, AFTER_DRAIN = false;
  bf16_t* PRWp; bf16_t* PRp;
  DEVINL void operator()(const AccT& acc, const pg8::Unit& u, int wr, int wc, int fr, int fq) const {
    const int rowbase = u.pm * 256 + wr * 64 + fr;
    EPI_CLOOP {
      const int col = u.pn * 256 + bj * 128 + wc * 32 + n * 16 + 4 * fq;
      EPI_RLOOP {
        const int row = rowbase + ai * 128 + m * 16;
        f32x4 v = acc[ai][bj][m][n];
        uint2 pk; pk.x = pk2(v[0], v[1]); pk.y = pk2(v[2], v[3]);
        if (col < PRW) *(uint2*)(PRWp + (size_t)row * PRW + col) = pk;
        else if (col < 3616) *(uint2*)(PRp + (size_t)row * PREST + (col - PRW)) = pk;
      }
    }
  }
};
struct EpiLora {
  static constexpr bool PERM = false, AFTER_DRAIN = false;
  bf16_t* Lo; const float* w0; const float* a0;
  DEVINL void operator()(const AccT& acc, const pg8::Unit& u, int wr, int wc, int fr, int fq) const {
    const int rowbase = u.pm * 256 + wr * 64 + fr;
    EPI_CLOOP {
      const int col = u.pn * 256 + bj * 128 + wc * 32 + n * 16 + 4 * fq;
      f32x4 b4 = (f32x4){0.f, 0.f, 0.f, 0.f};
      if (u.pn < 2) b4 = *(const f32x4*)(w0 + col);
      else if (u.pn < 4) b4 = *(const f32x4*)(a0 + (col - 512));
      EPI_RLOOP {
        const int row = rowbase + ai * 128 + m * 16;
        f32x4 v = acc[ai][bj][m][n] + b4;
        if (u.pn < 2) {
#pragma unroll
          for (int i = 0; i < 4; ++i) v[i] = 1.f - __expf(-0.6065306597126334f * sigm(v[i]));
        } else if (u.pn < 4) {
#pragma unroll
          for (int i = 0; i < 4; ++i) v[i] = sigm(v[i]);
        }
        uint2 pk; pk.x = pk2(v[0], v[1]); pk.y = pk2(v[2], v[3]);
        *(uint2*)(Lo + (size_t)row * 1280 + col) = pk;
      }
    }
  }
};
struct EpiGlu {
  static constexpr bool PERM = false, AFTER_DRAIN = false;
  const bf16_t* Yin; bf16_t* Yc; const float* bg;
  DEVINL void operator()(const AccT& acc, const pg8::Unit& u, int wr, int wc, int fr, int fq) const {
    const int rowbase = u.pm * 256 + wr * 64 + fr;
    EPI_CLOOP {
      const int col = bj * 128 + wc * 32 + n * 16 + 4 * fq;
      const f32x4 b4 = *(const f32x4*)(bg + col);
      EPI_RLOOP {
        const int row = rowbase + ai * 128 + m * 16;
        uint2 yr = *(const uint2*)(Yin + (size_t)row * 256 + col);
        f32x4 v = acc[ai][bj][m][n] + b4;
        float y0 = bf2f((bf16_t)(yr.x & 0xffff)), y1 = bf2f((bf16_t)(yr.x >> 16)), y2 = bf2f((bf16_t)(yr.y & 0xffff)), y3 = bf2f((bf16_t)(yr.y >> 16));
        uint2 pk; pk.x = pk2(y0 * sigm(v[0]), y1 * sigm(v[1])); pk.y = pk2(y2 * sigm(v[2]), y3 * sigm(v[3]));
        *(uint2*)(Yc + (size_t)row * 256 + col) = pk;
      }
    }
  }
};
struct EpiBranch {
  static constexpr bool PERM = false, AFTER_DRAIN = false;
  bf16_t* Br;
  DEVINL void operator()(const AccT& acc, const pg8::Unit& u, int wr, int wc, int fr, int fq) const {
    const int nb = u.pm / 144, pmr = u.pm - nb * 144;
    const int rowbase = pmr * 256 + wr * 64 + fr;
    EPI_CLOOP {
      const int col = u.pn * 256 + bj * 128 + wc * 32 + n * 16 + 4 * fq;
      EPI_RLOOP {
        const int row = rowbase + ai * 128 + m * 16;
        f32x4 v = acc[ai][bj][m][n];
        uint2 pk; pk.x = pk2(v[0], v[1]); pk.y = pk2(v[2], v[3]);
        *(uint2*)(Br + (size_t)row * 4096 + col) = pk;
      }
    }
  }
};
struct EpiGate {
  static constexpr bool PERM = false, AFTER_DRAIN = false;
  bf16_t* Br; const float* bgate;
  DEVINL void operator()(const AccT& acc, const pg8::Unit& u, int wr, int wc, int fr, int fq) const {
    const int rowbase = u.pm * 256 + wr * 64 + fr;
    EPI_CLOOP {
      const int col = u.pn * 256 + bj * 128 + wc * 32 + n * 16 + 4 * fq;
      const f32x4 b4 = *(const f32x4*)(bgate + col);
      EPI_RLOOP {
        const int row = rowbase + ai * 128 + m * 16;
        bf16_t* bp = Br + (size_t)row * 4096 + col;
        uint2 br = *(const uint2*)bp;
        f32x4 v = acc[ai][bj][m][n] + b4;
        float y0 = bf2f((bf16_t)(br.x & 0xffff)), y1 = bf2f((bf16_t)(br.x >> 16)), y2 = bf2f((bf16_t)(br.y & 0xffff)), y3 = bf2f((bf16_t)(br.y >> 16));
        uint2 pk; pk.x = pk2(y0 * sigm(v[0]), y1 * sigm(v[1])); pk.y = pk2(y2 * sigm(v[2]), y3 * sigm(v[3]));
        *(uint2*)bp = pk;
      }
    }
  }
};

template <class Epi, class Order = pg8::StaticOrder>
DEVINL void run_gemm(int wave, unsigned char* smem, const bf16_t* A, const bf16_t* Bt, int Mo, int N, int K, const Epi& E, int skip = 0) {
  asm volatile("" : "+s"(K), "+s"(N), "+s"(Mo));
  Order S; S.init(Mo, N, gridDim.x, blockIdx.x, skip);
  pg8::gemm_phase<Epi, Order>(wave, (PG8_LAS unsigned char*)smem, pg8::Gemm{A, Bt, Mo, N, K}, S, E);
}

#define XB_TMO      128
#define XB_XCNT(j)  (256  + 64 * (j))
#define XB_XSUB(j)  (1280 + 64 * (j))
#define XB_XGEN(j)  (2304 + 64 * (j))
#define XB_TOP      3328
#define XB_TOPGEN   3392
#define XCD_BAR_WORDS 3456
#define XB_SPIN_CAP (1u << 18)
#define XLAS __attribute__((address_space(3)))
DEVINL unsigned xb_ld(unsigned* p)              { return __hip_atomic_load(p, __ATOMIC_RELAXED, __HIP_MEMORY_SCOPE_AGENT); }
DEVINL unsigned xb_add(unsigned* p, unsigned v) { return __hip_atomic_fetch_add(p, v, __ATOMIC_RELAXED, __HIP_MEMORY_SCOPE_AGENT); }
DEVINL unsigned xb_xcc_id() { return (unsigned)__builtin_amdgcn_s_getreg((3 << 11) | 20) & 0xFu; }
#define XB_SPIN(cond, bar) do { unsigned _sp = 0; while (cond) { __builtin_amdgcn_s_sleep(1); \
    if ((++_sp & 255u) == 0u) { if (xb_ld(&(bar)[XB_TMO])) break; if (_sp > XB_SPIN_CAP) { atomicAdd(&(bar)[XB_TMO], 1u); break; } } } } while (0)
struct XcdBarrier { unsigned* bar; unsigned x; volatile XLAS unsigned* st; int wave; };
DEVINL XcdBarrier xcd_barrier_post(int wave, unsigned* bar, volatile XLAS unsigned* st) {
    XcdBarrier b; b.bar = bar; b.x = xb_xcc_id(); b.st = st; b.wave = wave;
    if (otid(wave) == 0) (void)xb_add(&bar[XB_XCNT(b.x)], 1u);
    return b;
}
DEVINL void xcd_barrier_complete(unsigned* bar, unsigned x, unsigned& nloc, unsigned& nx) {
    const unsigned G = gridDim.x * gridDim.y * gridDim.z;
    unsigned sum, cnt, mine, sp = 0u;
    for (;;) {
        sum = 0u; cnt = 0u; mine = 0u;
#pragma unroll
        for (unsigned j = 0; j < 16; ++j) { const unsigned c = xb_ld(&bar[XB_XCNT(j)]); sum += c; cnt += (c > 0u) ? 1u : 0u; mine = (j == x) ? c : mine; }
        if (sum == G) break;
        __builtin_amdgcn_s_sleep(1);
        if ((++sp & 255u) == 0u) { if (xb_ld(&bar[XB_TMO])) break; if (sp > XB_SPIN_CAP) { atomicAdd(&bar[XB_TMO], 1u); break; } }
    }
    nloc = mine > 0u ? mine : 1u; nx = cnt > 0u ? cnt : 1u;
}
DEVINL void xcd_barrier(const Params& p, unsigned char* smem) {
    XcdBarrier b; b.bar = (unsigned*)(p.ws + OFF_BAR); b.x = xb_xcc_id(); b.st = (volatile XLAS unsigned*)(XLAS unsigned char*)(smem + 131072); b.wave = p.wave;
    asm volatile("s_waitcnt vmcnt(0)" ::: "memory");
    __syncthreads();
    if (otid(b.wave) == 0) {
        unsigned* bar = b.bar;
        __builtin_amdgcn_s_waitcnt(0);
        unsigned nloc = b.st[0], nx = b.st[1];
        if (nloc == 0u) { xcd_barrier_complete(bar, b.x, nloc, nx); b.st[0] = nloc; b.st[1] = nx; }
        const unsigned old = xb_add(&bar[XB_XSUB(b.x)], 1u);
        const unsigned gen = old / nloc;
        if (old + 1u == (gen + 1u) * nloc) {
            __builtin_amdgcn_fence(__ATOMIC_RELEASE, "agent");
            asm volatile("s_waitcnt vmcnt(0)" ::: "memory");
            const unsigned og = xb_add(&bar[XB_TOP], 1u);
            const unsigned tg = og / nx;
            if (og + 1u == (tg + 1u) * nx) xb_add(&bar[XB_TOPGEN], 1u);
            else XB_SPIN(xb_ld(&bar[XB_TOPGEN]) == tg, bar);
            __builtin_amdgcn_fence(__ATOMIC_ACQUIRE, "agent");
            xb_add(&bar[XB_XGEN(b.x)], 1u);
            asm volatile("s_waitcnt vmcnt(0)" ::: "memory");
        } else {
            XB_SPIN(xb_ld(&bar[XB_XGEN(b.x)]) == gen, bar);
            __builtin_amdgcn_fence(__ATOMIC_ACQUIRE, "agent");
            asm volatile("s_waitcnt vmcnt(0)" ::: "memory");
        }
    }
    __syncthreads();
}

DEVINL void phase_lnmod(const Params& p, bool from_input, bool do_ln, int lnl, int lnj, int ml, int mj,
                        bf16_t* H, bool final_out, bool skipctx = false) {
  char* ws = p.ws;
  float* X = (float*)(ws + OFF_X);
  const float* Mod = (const float*)(ws + OFF_MOD);
  const int lane = otid(p.wave) & 63, wid = otid(p.wave) >> 6;
  const int gw = blockIdx.x * 8 + wid, nw = gridDim.x * 8;
  const float* g = p.in[6] + (size_t)(lnl * 3 + lnj) * 1024;
  const float* bb = p.in[7] + (size_t)(lnl * 3 + lnj) * 1024;
  for (int row = gw; row < MROWS; row += nw) {
    int b = row / SEQT, pos = row - b * SEQT;
    if (skipctx && pos < 256) continue;
    int mr = pos < 256 ? 16 : b;
    const float* src;
    if (from_input) src = (pos < 256) ? (p.in[2] + (size_t)(b * 256 + pos) * 1024) : (p.in[0] + (size_t)(b * 2048 + pos - 256) * 1024);
    else src = X + (size_t)row * 1024;
    float4 v[4];
#pragma unroll
    for (int i = 0; i < 4; ++i) v[i] = *(const float4*)(src + i * 256 + lane * 4);
    if (do_ln) {
      float s = 0.f;
#pragma unroll
      for (int i = 0; i < 4; ++i) s += v[i].x + v[i].y + v[i].z + v[i].w;
      float mean = wave_sum(s) * (1.f / 1024.f);
      float q = 0.f;
#pragma unroll
      for (int i = 0; i < 4; ++i) {
        v[i].x -= mean; v[i].y -= mean; v[i].z -= mean; v[i].w -= mean;
        q += v[i].x * v[i].x + v[i].y * v[i].y + v[i].z * v[i].z + v[i].w * v[i].w;
      }
      float rs = rsqrtf(wave_sum(q) * (1.f / 1024.f) + 1e-5f);
#pragma unroll
      for (int i = 0; i < 4; ++i) {
        float4 gg = *(const float4*)(g + i * 256 + lane * 4);
        float4 b4 = *(const float4*)(bb + i * 256 + lane * 4);
        v[i].x = v[i].x * rs * gg.x + b4.x; v[i].y = v[i].y * rs * gg.y + b4.y;
        v[i].z = v[i].z * rs * gg.z + b4.z; v[i].w = v[i].w * rs * gg.w + b4.w;
      }
    }
    if (final_out) {
      if (pos >= 256) {
        float* o = p.out + (size_t)(b * 2048 + pos - 256) * 1024;
#pragma unroll
        for (int i = 0; i < 4; ++i) *(float4*)(o + i * 256 + lane * 4) = v[i];
      }
    } else {
      const float* sh = Mod + (size_t)(ml * 17 + mr) * 9216 + mj * 1024;
      const float* sc = sh + 1024;
#pragma unroll
      for (int i = 0; i < 4; ++i) {
        if (from_input || do_ln) *(float4*)(X + (size_t)row * 1024 + i * 256 + lane * 4) = v[i];
        float4 s4 = *(const float4*)(sh + i * 256 + lane * 4);
        float4 c4 = *(const float4*)(sc + i * 256 + lane * 4);
        unsigned h0 = f2bf(v[i].x * (1.f + c4.x) + s4.x), h1 = f2bf(v[i].y * (1.f + c4.y) + s4.y);
        unsigned h2 = f2bf(v[i].z * (1.f + c4.z) + s4.z), h3 = f2bf(v[i].w * (1.f + c4.w) + s4.w);
        uint2 pk; pk.x = h0 | (h1 << 16); pk.y = h2 | (h3 << 16);
        *(uint2*)(H + (size_t)row * 1024 + i * 256 + lane * 4) = pk;
      }
    }
  }
}

DEVINL void phase_ada_partial(const Params& p, float* smf) {
  float* MODP = (float*)(p.ws + OFF_AR + AR_MODP);
  const int tid = otid(p.wave) & 255, half = otid(p.wave) >> 8;
  float* sm = smf + half * 5120;
  for (int it0 = blockIdx.x * 2; it0 < 576; it0 += gridDim.x * 2) {
    int it = it0 + half; bool valid = it < 576; if (!valid) it = 575;
    int kq = it & 3, cb = it >> 2;
    int col = cb * 256 + tid;
    int l = col / 9216, n = col - l * 9216;
    for (int idx = tid; idx < 256 * 17; idx += 256) {
      int r = idx >> 8, k = idx & 255;
      float val = (r < 16) ? p.in[1][r * 1024 + kq * 256 + k] : p.in[3][kq * 256 + k];
      sm[k * 20 + r] = silu(val);
    }
    __syncthreads();
    float acc[17];
#pragma unroll
    for (int r = 0; r < 17; ++r) acc[r] = 0.f;
    const float* w = p.in[4] + ((size_t)l * 1024 + kq * 256) * 9216 + n;
#pragma unroll 4
    for (int k = 0; k < 256; ++k) {
      float wv = w[(size_t)k * 9216];
      const float4* s4 = (const float4*)(sm + k * 20);
      float4 a0 = s4[0], a1 = s4[1], a2 = s4[2], a3 = s4[3];
      float a16 = sm[k * 20 + 16];
      acc[0] += a0.x * wv; acc[1] += a0.y * wv; acc[2] += a0.z * wv; acc[3] += a0.w * wv;
      acc[4] += a1.x * wv; acc[5] += a1.y * wv; acc[6] += a1.z * wv; acc[7] += a1.w * wv;
      acc[8] += a2.x * wv; acc[9] += a2.y * wv; acc[10] += a2.z * wv; acc[11] += a2.w * wv;
      acc[12] += a3.x * wv; acc[13] += a3.y * wv; acc[14] += a3.z * wv; acc[15] += a3.w * wv;
      acc[16] += a16 * wv;
    }
    if (valid) {
#pragma unroll
      for (int r = 0; r < 17; ++r) MODP[((size_t)(kq * 4 + l) * 17 + r) * 9216 + n] = acc[r];
    }
    __syncthreads();
  }
}

DEVINL void phase_ada_reduce(const Params& p) {
  const float* MODP = (const float*)(p.ws + OFF_AR + AR_MODP);
  float* Mod = (float*)(p.ws + OFF_MOD);
  const int total = 4 * 17 * 9216;
  for (int idx = blockIdx.x * 512 + otid(p.wave); idx < total; idx += gridDim.x * 512) {
    int n = idx % 9216; int l = idx / (17 * 9216);
    float s = p.in[5][l * 9216 + n];
#pragma unroll
    for (int kq = 0; kq < 4; ++kq) s += MODP[(size_t)kq * total + idx];
    Mod[idx] = s;
  }
}

DEVINL void phase_tables(const Params& p) {
  float* TAB = (float*)(p.ws + OFF_TAB);
  int idx = blockIdx.x * 512 + otid(p.wave);
  if (idx < 1024) {
    int n = idx >> 4, j = idx & 15;
    float inv = powf(10000.f, -(float)j / 16.f);
    float ang = (float)n * inv;
    TAB[idx] = cosf(ang);
    TAB[1024 + idx] = sinf(ang);
  } else if (idx < 1280) {
    int c = idx - 1024;
    const float* lg = p.in[33];
    float v0 = lg[c], v1 = lg[256 + c], v2 = lg[512 + c], v3 = lg[768 + c];
    float mx = fmaxf(fmaxf(v0, v1), fmaxf(v2, v3));
    float e0 = expf(v0 - mx), e1 = expf(v1 - mx), e2 = expf(v2 - mx), e3 = expf(v3 - mx);
    float inv = 1.f / (e0 + e1 + e2 + e3);
    float s0 = e0 * inv, s1 = e1 * inv, s2 = e2 * inv, s3 = e3 * inv;
    float c0 = s0, c1 = c0 + s1, c2 = c1 + s2, c3 = c2 + s3;
    TAB[2048 + c] = c0 - s0;
    TAB[2048 + 256 + c] = c1 - s0;
    TAB[2048 + 512 + c] = c2 - s0;
    TAB[2048 + 768 + c] = c3 - s0;
  }
}


struct F4 { float a, b, c, d; };
DEVINL F4 ld4bf(const bf16_t* p) { uint2 r = *(const uint2*)p; F4 o; o.a = __uint_as_float(r.x << 16); o.b = __uint_as_float(r.x & 0xffff0000u); o.c = __uint_as_float(r.y << 16); o.d = __uint_as_float(r.y & 0xffff0000u); return o; }
DEVINL void st4bf(bf16_t* p, float a, float b, float c, float d) { uint2 r; r.x = pk2(a, b); r.y = pk2(c, d); *(uint2*)p = r; }
DEVINL F4 ld4f(const float* p) { float4 r = *(const float4*)p; F4 o; o.a = r.x; o.b = r.y; o.c = r.z; o.d = r.w; return o; }
DEVINL float row16_sum(float x) {
  x += __int_as_float(__builtin_amdgcn_update_dpp(0, __float_as_int(x), 0xB1, 0xF, 0xF, true));
  x += __int_as_float(__builtin_amdgcn_update_dpp(0, __float_as_int(x), 0x4E, 0xF, 0xF, true));
  x += __int_as_float(__builtin_amdgcn_update_dpp(0, __float_as_int(x), 0x141, 0xF, 0xF, true));
  x += __int_as_float(__builtin_amdgcn_update_dpp(0, __float_as_int(x), 0x140, 0xF, 0xF, true));
  return x;
}
DEVINL void phase_shift(const Params& p, int l) {
  char* ws = p.ws;
  const bf16_t* PRWp = (const bf16_t*)(ws + OFF_AR + AR_PRW);
  bf16_t* RKV = (bf16_t*)(ws + OFF_AR + AR_RKV);
  bf16_t* A2 = (bf16_t*)(ws + OFF_AR + AR_A2);
  const float* mu = p.in[12] + (size_t)l * PRW;
  bf16_t* PRp = (bf16_t*)(ws + OFF_AR + AR_PREST);
  const float* TABp = (const float*)(ws + OFF_TAB);
  const int lane = otid(p.wave) & 63, wid = otid(p.wave) >> 6;
  const int gw = blockIdx.x * 8 + wid, nw = gridDim.x * 8;
  const int c4 = lane * 4;
  for (int row = gw; row < MROWS; row += nw) {
    int b = row / SEQT, pos = row - b * SEQT;
    const bool hasp = !(pos == 0 || pos == 256);
    const bool hasn = !(pos == 255 || pos == 2303);
    const bf16_t* pr = PRWp + (size_t)row * PRW;
#pragma unroll
    for (int it = 0; it < 5; ++it) {
      const int c = it * 256 + c4;
      if (it < 4 || lane < 8) {
        F4 x0 = ld4bf(pr + c);
        F4 xp = {0.f, 0.f, 0.f, 0.f}, xn = {0.f, 0.f, 0.f, 0.f};
        if (hasp) xp = ld4bf(pr + c - PRW);
        if (hasn) xn = ld4bf(pr + c + PRW);
        F4 m = ld4f(mu + c);
        float s0 = x0.a + m.a * (0.5f * (xp.a + xn.a) - x0.a);
        float s1 = x0.b + m.b * (0.5f * (xp.b + xn.b) - x0.b);
        float s2 = x0.c + m.c * (0.5f * (xp.c + xn.c) - x0.c);
        float s3 = x0.d + m.d * (0.5f * (xp.d + xn.d) - x0.d);
        if (it < 3) {
          st4bf(RKV + (size_t)row * 1024 + c, s0, s1, s2, s3);
          if (it == 1) {
            F4 kc = ld4f(p.in[18] + l * 256 + (c - 256));
            float k0 = s0 * kc.a, k1 = s1 * kc.b, k2 = s2 * kc.c, k3 = s3 * kc.d;
            float nrm = row16_sum(k0 * k0 + k1 * k1 + k2 * k2 + k3 * k3);
            float rs = rsqrtf(fmaxf(nrm, 1e-12f));
            st4bf(RKV + (size_t)row * 1024 + 512 + c, k0 * rs, k1 * rs, k2 * rs, k3 * rs);
          }
        } else if (c < 832) st4bf(A2 + (size_t)row * 384 + (c - 768), tanh_fast(s0), tanh_fast(s1), tanh_fast(s2), tanh_fast(s3));
        else if (c < 896) st4bf(A2 + (size_t)row * 384 + (c - 768), s0, s1, s2, s3);
        else st4bf(A2 + (size_t)row * 384 + 128 + (c - 896), sigm(s0), sigm(s1), sigm(s2), sigm(s3));
      }
    }
    if (lane < 24) *(uint2*)(A2 + (size_t)row * 384 + 288 + c4) = make_uint2(0u, 0u);
    {
      bf16_t* prr = PRp + (size_t)row * PREST;
      const int d = c4 & 63, jj = d & 31, fi = jj & 15;
      F4 cs = {1.f, 1.f, 1.f, 1.f}, sn = {0.f, 0.f, 0.f, 0.f};
      if (pos >= 256) {
        const int t = pos - 256; const int n = jj < 16 ? (t >> 6) : (t & 63);
        cs = ld4f(TABp + n * 16 + fi); sn = ld4f(TABp + 1024 + n * 16 + fi);
      }
      const int cp = c4 ^ 32;
      F4 xq = ld4bf(prr + c4), xqp = ld4bf(prr + cp), xk = ld4bf(prr + 256 + c4), xkp = ld4bf(prr + 256 + cp);
      const float sg = (d < 32) ? -1.f : 1.f;
      asm volatile("" ::: "memory");
      st4bf(prr + c4, xq.a * cs.a + sg * xqp.a * sn.a, xq.b * cs.b + sg * xqp.b * sn.b, xq.c * cs.c + sg * xqp.c * sn.c, xq.d * cs.d + sg * xqp.d * sn.d);
      st4bf(prr + 256 + c4, 0.125f * (xk.a * cs.a + sg * xkp.a * sn.a), 0.125f * (xk.b * cs.b + sg * xkp.b * sn.b),
            0.125f * (xk.c * cs.c + sg * xkp.c * sn.c), 0.125f * (xk.d * cs.d + sg * xkp.d * sn.d));
      F4 lb = ld4f(TABp + 2048 + l * 256 + c4);
      F4 zf = ld4bf(prr + 1536 + c4), zb = ld4bf(prr + 1792 + c4);
      F4 f0 = ld4f(p.in[34] + (l * 2 + 0) * 256 + c4), f1 = ld4f(p.in[34] + (l * 2 + 1) * 256 + c4);
      st4bf(prr + 1536 + c4, (1.f - lb.a) * sigm(-(zf.a + f0.a)), (1.f - lb.b) * sigm(-(zf.b + f0.b)), (1.f - lb.c) * sigm(-(zf.c + f0.c)), (1.f - lb.d) * sigm(-(zf.d + f0.d)));
      st4bf(prr + 1792 + c4, (1.f - lb.a) * sigm(-(zb.a + f1.a)), (1.f - lb.b) * sigm(-(zb.b + f1.b)), (1.f - lb.c) * sigm(-(zb.c + f1.c)), (1.f - lb.d) * sigm(-(zb.d + f1.d)));
    }
  }
}

DEVINL int vrow(int b, int dir, int pp) {
  int pos = dir ? (pp < 256 ? 255 - pp : 2559 - pp) : pp;
  return b * SEQT + pos;
}

typedef float v2f __attribute__((ext_vector_type(2)));
#ifdef NOSB
#define SB()
#else
#define SB() __builtin_amdgcn_sched_barrier(0)
#endif
#define LO2(t) __builtin_shufflevector(t, t, 0, 1)
#define HI2(t) __builtin_shufflevector(t, t, 2, 3)
DEVINL void wave_lds_sync() {
  __builtin_amdgcn_fence(__ATOMIC_RELEASE, "wavefront");
  __builtin_amdgcn_wave_barrier();
  __builtin_amdgcn_fence(__ATOMIC_ACQUIRE, "wavefront");
}

DEVINL float dpp_xor1(float x) { return __int_as_float(__builtin_amdgcn_update_dpp(0, __float_as_int(x), 0xB1, 0xF, 0xF, true)); }
DEVINL float dpp_xor2(float x) { return __int_as_float(__builtin_amdgcn_update_dpp(0, __float_as_int(x), 0x4E, 0xF, 0xF, true)); }

typedef _Float16 h2 __attribute__((ext_vector_type(2)));
typedef _Float16 h8 __attribute__((ext_vector_type(8)));
#define H2(q, j) (h2{(q)[2 * (j)], (q)[2 * (j) + 1]})
DEVINL void scan_rwkv(const Params& p, int l, int b, int dir, int h, int quarter, int lane, float* sw) {
  asm volatile("" : "+v"(lane));
  __builtin_amdgcn_s_setprio(3);
  char* ws = p.ws;
  const bf16_t* RKV = (const bf16_t*)(ws + OFF_AR + AR_RKV);
  const bf16_t* L = (const bf16_t*)(ws + OFF_AR + AR_L);
  bf16_t* O = (bf16_t*)(ws + OFF_AR + AR_OUT) + (size_t)(dir ? 4 : 0) * OUTSLOT;
  const int c = h * 64 + lane;
  const int kp = lane & 3, myrow = quarter * 16 + (lane >> 2);
  const float kac = p.in[19][l * 256 + c];
  h2 S[8];
#pragma unroll
  for (int k = 0; k < 8; ++k) S[k] = h2{(_Float16)0.f, (_Float16)0.f};
  bf16_t rr[8], rk[8], rv[8], rkk[8], rw[8], ra[8];
#define RWKV_LOADRAW(CH)                                                  \
  _Pragma("unroll") for (int s = 0; s < 8; ++s) {                         \
    int row = vrow(b, dir, (CH) * 8 + s);                                 \
    rr[s] = RKV[(size_t)row * 1024 + c];                                  \
    rk[s] = RKV[(size_t)row * 1024 + 256 + c];                            \
    rv[s] = RKV[(size_t)row * 1024 + 512 + c];                            \
    rkk[s] = RKV[(size_t)row * 1024 + 768 + c];                           \
    rw[s] = L[(size_t)row * 1280 + dir * 256 + c];                        \
    ra[s] = L[(size_t)row * 1280 + 512 + dir * 256 + c];                  \
  }
#define RWKV_LD(Q, VV, S_)                                                              \
  { const float* base_ = sw + (S_) * 224;                                               \
    _Pragma("unroll") for (int a = 0; a < 5; ++a) {                                     \
      Q[2 * a] = *(const h8*)(base_ + a * 32 + kp * 8);                                 \
      Q[2 * a + 1] = *(const h8*)(base_ + a * 32 + kp * 8 + 4); }                       \
    VV = base_[160 + myrow]; }
#define RWKV_CMP(Q, VV, S_)                                                             \
  { h2 sa0 = h2{(_Float16)0.f, (_Float16)0.f}, sa1 = sa0;                               \
    _Pragma("unroll") for (int i = 0; i < 4; ++i) { sa0 += S[i] * H2(Q[0], i); sa1 += S[4 + i] * H2(Q[1], i); } \
    float sa = ((float)sa0.x + (float)sa0.y) + ((float)sa1.x + (float)sa1.y);           \
    sa += dpp_xor1(sa); sa += dpp_xor2(sa);                                             \
    const h2 sasa = h2{(_Float16)sa, (_Float16)sa}, vv = h2{(_Float16)(VV), (_Float16)(VV)}; \
    h2 y0 = h2{(_Float16)0.f, (_Float16)0.f}, y1 = y0;                                  \
    _Pragma("unroll") for (int g = 0; g < 2; ++g) _Pragma("unroll") for (int i = 0; i < 4; ++i) { \
      const h2 nw = H2(Q[2 + g], i), bq = H2(Q[4 + g], i), dq = H2(Q[6 + g], i), rq = H2(Q[8 + g], i); \
      const h2 t = vv * dq - sasa * bq;                                                 \
      const h2 u = S[4 * g + i] + t;                                                    \
      S[4 * g + i] = S[4 * g + i] * nw + u;                                             \
      if (g == 0) y0 += S[4 * g + i] * rq; else y1 += S[4 * g + i] * rq;                \
    }                                                                                   \
    float y = ((float)y0.x + (float)y0.y) + ((float)y1.x + (float)y1.y);                \
    y += dpp_xor1(y); y += dpp_xor2(y);                                                 \
    if (kp == 0) { int row = vrow(b, dir, ch * 8 + (S_)); O[(size_t)row * 256 + h * 64 + myrow] = f2bf(y); } }
  RWKV_LOADRAW(0)
#pragma unroll 1
  for (int ch = 0; ch < 288; ++ch) {
#pragma unroll
    for (int s = 0; s < 8; ++s) {
      float r_ = bf2f(rr[s]), k_ = bf2f(rk[s]), v_ = bf2f(rv[s]), kk_ = bf2f(rkk[s]);
      float omw = bf2f(rw[s]), a_ = bf2f(ra[s]);
      float kd_ = k_ * (1.f + (a_ - 1.f) * kac);
      _Float16* q = (_Float16*)(sw + s * 224);
      q[lane] = (_Float16)kk_; q[64 + lane] = (_Float16)(-omw); q[128 + lane] = (_Float16)(kk_ * a_); q[192 + lane] = (_Float16)kd_; q[256 + lane] = (_Float16)r_;
      sw[s * 224 + 160 + lane] = v_;
    }
    wave_lds_sync();
    if (ch + 1 < 288) { RWKV_LOADRAW(ch + 1) }
    SB();
    h8 QA[10], QB[10]; float vA, vB;
    RWKV_LD(QA, vA, 0) SB();
    RWKV_LD(QB, vB, 1) SB(); RWKV_CMP(QA, vA, 0) SB();
    RWKV_LD(QA, vA, 2) SB(); RWKV_CMP(QB, vB, 1) SB();
    RWKV_LD(QB, vB, 3) SB(); RWKV_CMP(QA, vA, 2) SB();
    RWKV_LD(QA, vA, 4) SB(); RWKV_CMP(QB, vB, 3) SB();
    RWKV_LD(QB, vB, 5) SB(); RWKV_CMP(QA, vA, 4) SB();
    RWKV_LD(QA, vA, 6) SB(); RWKV_CMP(QB, vB, 5) SB();
    RWKV_LD(QB, vB, 7) SB(); RWKV_CMP(QA, vA, 6) SB();
    RWKV_CMP(QB, vB, 7) SB();
    wave_lds_sync();
  }
  __builtin_amdgcn_s_setprio(0);
#undef RWKV_LOADRAW
#undef RWKV_LD
#undef RWKV_CMP
}

template <int MODE>
DEVINL void scan_gla(const Params& p, int l, int b, int dir, int h, int quarter, int lane, float* sw) {
  asm volatile("" : "+v"(lane));
  __builtin_amdgcn_s_setprio(3);
  char* ws = p.ws;
  const bf16_t* PR = (const bf16_t*)(ws + OFF_AR + AR_PREST);
  bf16_t* O = (bf16_t*)(ws + OFF_AR + AR_OUT) + (size_t)(MODE == 0 ? (dir ? 6 : 3) : (dir ? 5 : 1)) * OUTSLOT;
  const int c = h * 64 + lane;
  const int dp = lane & 3, mycol = quarter * 16 + (lane >> 2);
  const float gamma = 1.f - exp2f(-5.f - (float)h);
  const h2 g2 = h2{(_Float16)gamma, (_Float16)gamma};
  h2 S[8];
#pragma unroll
  for (int k = 0; k < 8; ++k) S[k] = h2{(_Float16)0.f, (_Float16)0.f};
  bf16_t r0[8], r1[8], r2[8];
  const int cA = (MODE == 0) ? ((dir ? 1792 : 1536) + c) : (256 + c);
  const int cQ = (MODE == 0) ? (1280 + c) : c;
  const int cV = (MODE == 0) ? (2048 + c) : (512 + c);
#define GLA_LOADRAW(CH)                                                              \
  _Pragma("unroll") for (int s = 0; s < 8; ++s) {                                    \
    int row = vrow(b, dir, (CH) * 8 + s);                                            \
    const bf16_t* pr = PR + (size_t)row * PREST;                                     \
    r0[s] = pr[cA]; r1[s] = pr[cQ]; r2[s] = pr[cV];                                  \
  }
#define GLA_LD(Q, VV, S_)                                                            \
  { const float* base_ = sw + (S_) * 128;                                            \
    Q[0] = *(const h8*)(base_ + dp * 8); Q[1] = *(const h8*)(base_ + dp * 8 + 4);    \
    Q[2] = *(const h8*)(base_ + 32 + dp * 8); Q[3] = *(const h8*)(base_ + 32 + dp * 8 + 4); \
    VV = base_[64 + mycol]; }
#define GLA_CMP(Q, VV, S_)                                                           \
  { const h2 vv = h2{(_Float16)(VV), (_Float16)(VV)}; h2 o0 = h2{(_Float16)0.f, (_Float16)0.f}, o1 = o0; \
    _Pragma("unroll") for (int g_ = 0; g_ < 2; ++g_) _Pragma("unroll") for (int i = 0; i < 4; ++i) { \
      const h2 a2 = H2(Q[g_], i), q2 = H2(Q[2 + g_], i);                             \
      if (MODE == 0) {                      \
        S[4 * g_ + i] = S[4 * g_ + i] - a2 * (S[4 * g_ + i] - vv);                   \
        if (g_ == 0) o0 += S[4 * g_ + i] * q2; else o1 += S[4 * g_ + i] * q2;        \
      } else {                                                                       \
        if (dir) { if (g_ == 0) o0 += S[4 * g_ + i] * q2; else o1 += S[4 * g_ + i] * q2; } \
        S[4 * g_ + i] = g2 * S[4 * g_ + i] + a2 * vv;                                \
        if (!dir) { if (g_ == 0) o0 += S[4 * g_ + i] * q2; else o1 += S[4 * g_ + i] * q2; } \
      }                                                                              \
    }                                                                                \
    float o = ((float)o0.x + (float)o0.y) + ((float)o1.x + (float)o1.y);             \
    o += dpp_xor1(o); o += dpp_xor2(o);                                              \
    if (dp == 0) { int row = vrow(b, dir, ch * 8 + (S_)); O[(size_t)row * 256 + h * 64 + mycol] = f2bf(o); } }
  GLA_LOADRAW(0)
#pragma unroll 1
  for (int ch = 0; ch < 288; ++ch) {
#pragma unroll
    for (int s = 0; s < 8; ++s) {
      _Float16* q = (_Float16*)(sw + s * 128);
      q[lane] = (_Float16)bf2f(r0[s]); q[64 + lane] = (_Float16)bf2f(r1[s]);
      sw[s * 128 + 64 + lane] = bf2f(r2[s]);
    }
    wave_lds_sync();
    if (ch + 1 < 288) { GLA_LOADRAW(ch + 1) }
    SB();
    h8 QA[4], QB[4]; float vA, vB;
    GLA_LD(QA, vA, 0) SB();
    GLA_LD(QB, vB, 1) SB(); GLA_CMP(QA, vA, 0) SB();
    GLA_LD(QA, vA, 2) SB(); GLA_CMP(QB, vB, 1) SB();
    GLA_LD(QB, vB, 3) SB(); GLA_CMP(QA, vA, 2) SB();
    GLA_LD(QA, vA, 4) SB(); GLA_CMP(QB, vB, 3) SB();
    GLA_LD(QB, vB, 5) SB(); GLA_CMP(QA, vA, 4) SB();
    GLA_LD(QA, vA, 6) SB(); GLA_CMP(QB, vB, 5) SB();
    GLA_LD(QB, vB, 7) SB(); GLA_CMP(QA, vA, 6) SB();
    GLA_CMP(QB, vB, 7) SB();
    wave_lds_sync();
  }
  __builtin_amdgcn_s_setprio(0);
#undef GLA_LOADRAW
#undef GLA_LD
#undef GLA_CMP
}

DEVINL void scan_s5(const Params& p, int l, int b, int dir, int g, int lane, float* smC) {
  asm volatile("" : "+v"(lane));
  char* ws = p.ws;
  const bf16_t* PR = (const bf16_t*)(ws + OFF_AR + AR_PREST);
  bf16_t* O = (bf16_t*)(ws + OFF_AR + AR_OUT) + (size_t)(dir ? 7 : 8) * OUTSLOT;
  _Float16* hC = (_Float16*)smC;
  _Float16* hS = (_Float16*)(smC + 1024);
  float* smU = smC + 2048;
  const size_t gi = (size_t)((l * 2 + dir) * 16 + g);
  float lbr, lbi; h2 bb[16];
  {
    float lr = p.in[23][gi * 64 + lane], li = p.in[24][gi * 64 + lane];
    float dt = expf(p.in[25][gi]);
    float mag = expf(lr * dt);
    lbr = mag * cosf(li * dt); lbi = mag * sinf(li * dt);
    float den = lr * lr + li * li;
    float fre = ((lbr - 1.f) * lr + lbi * li) / den;
    float fim = (lbi * lr - (lbr - 1.f) * li) / den;
    const float* br = p.in[26] + (gi * 64 + lane) * 16;
    const float* bi = p.in[27] + (gi * 64 + lane) * 16;
#pragma unroll
    for (int i = 0; i < 16; ++i) {
      float r_ = br[i], i_ = bi[i];
      bb[i] = h2{(_Float16)(fre * r_ - fim * i_), (_Float16)(fre * i_ + fim * r_)};
    }
    const float* cr = p.in[28] + gi * 1024;
    const float* ci = p.in[29] + gi * 1024;
#pragma unroll
    for (int o = 0; o < 16; ++o) {
      hC[(o * 2 + 0) * 64 + lane] = (_Float16)cr[o * 64 + lane];
      hC[(o * 2 + 1) * 64 + lane] = (_Float16)ci[o * 64 + lane];
    }
  }
  float sre = 0.f, sim = 0.f;
  const int ts = lane >> 2, i4 = lane & 3;
  uint2 raw = *(const uint2*)(PR + (size_t)vrow(b, dir, ts) * PREST + 1024 + g * 16 + i4 * 4);
#pragma unroll 1
  for (int ch = 0; ch < 144; ++ch) {
    {
      h2 d0, d1, d2, d3;
      _Float16 u0 = (_Float16)bf2f((bf16_t)(raw.x & 0xffff)), u1 = (_Float16)bf2f((bf16_t)(raw.x >> 16));
      _Float16 u2 = (_Float16)bf2f((bf16_t)(raw.y & 0xffff)), u3 = (_Float16)bf2f((bf16_t)(raw.y >> 16));
      d0 = h2{u0, u0}; d1 = h2{u1, u1}; d2 = h2{u2, u2}; d3 = h2{u3, u3};
      h8 pk = h8{d0.x, d0.y, d1.x, d1.y, d2.x, d2.y, d3.x, d3.y};
      *(h8*)(smU + ts * 16 + i4 * 4) = pk;
    }
    wave_lds_sync();
    if (ch + 1 < 144) raw = *(const uint2*)(PR + (size_t)vrow(b, dir, (ch + 1) * 16 + ts) * PREST + 1024 + g * 16 + i4 * 4);
#pragma unroll 4
    for (int s = 0; s < 16; ++s) {
      const h8* u = (const h8*)(smU + s * 16);
      h8 u0 = u[0], u1 = u[1], u2 = u[2], u3 = u[3];
      h2 a0 = bb[0] * H2(u0, 0), a1 = bb[1] * H2(u0, 1);
      a0 += bb[2] * H2(u0, 2); a1 += bb[3] * H2(u0, 3);
      a0 += bb[4] * H2(u1, 0); a1 += bb[5] * H2(u1, 1);
      a0 += bb[6] * H2(u1, 2); a1 += bb[7] * H2(u1, 3);
      a0 += bb[8] * H2(u2, 0); a1 += bb[9] * H2(u2, 1);
      a0 += bb[10] * H2(u2, 2); a1 += bb[11] * H2(u2, 3);
      a0 += bb[12] * H2(u3, 0); a1 += bb[13] * H2(u3, 1);
      a0 += bb[14] * H2(u3, 2); a1 += bb[15] * H2(u3, 3);
      const float bur = (float)a0.x + (float)a1.x, bui = (float)a0.y + (float)a1.y;
      float nre = lbr * sre - lbi * sim + bur;
      float nim = lbr * sim + lbi * sre + bui;
      sre = nre; sim = nim;
      hS[(s * 2 + 0) * 64 + lane] = (_Float16)sre;
      hS[(s * 2 + 1) * 64 + lane] = (_Float16)sim;
    }
    wave_lds_sync();
    {
      h2 acc[4];
#pragma unroll
      for (int oo = 0; oo < 4; ++oo) acc[oo] = h2{(_Float16)0.f, (_Float16)0.f};
      const _Float16* sr = hS + (ts * 2 + 0) * 64;
      const _Float16* si = hS + (ts * 2 + 1) * 64;
#pragma unroll 4
      for (int p8 = 0; p8 < 8; ++p8) {
        h8 a = *(const h8*)(sr + p8 * 8), bq = *(const h8*)(si + p8 * 8);
#pragma unroll
        for (int oo = 0; oo < 4; ++oo) {
          int o = i4 * 4 + oo;
          h8 cr8 = *(const h8*)(hC + (o * 2 + 0) * 64 + p8 * 8);
          h8 ci8 = *(const h8*)(hC + (o * 2 + 1) * 64 + p8 * 8);
#pragma unroll
          for (int j = 0; j < 4; ++j) { acc[oo] += H2(cr8, j) * H2(a, j); acc[oo] -= H2(ci8, j) * H2(bq, j); }
        }
      }
      int row = vrow(b, dir, ch * 16 + ts);
      uint2 pk;
      pk.x = (unsigned)f2bf((float)acc[0].x + (float)acc[0].y) | ((unsigned)f2bf((float)acc[1].x + (float)acc[1].y) << 16);
      pk.y = (unsigned)f2bf((float)acc[2].x + (float)acc[2].y) | ((unsigned)f2bf((float)acc[3].x + (float)acc[3].y) << 16);
      *(uint2*)(O + (size_t)row * 256 + g * 16 + i4 * 4) = pk;
    }
    wave_lds_sync();
  }
}

DEVINL void phase_scans(const Params& p, int l, float* smf) {
  const int tid = otid(p.wave), lane = tid & 63, wid = __builtin_amdgcn_readfirstlane(tid >> 6);
  for (int task = blockIdx.x; task < 256; task += gridDim.x) {
    if (wid < 2) {
      const int chain = task >> 1, quarter = (task & 1) * 2 + wid;
      scan_rwkv(p, l, chain >> 3, (chain >> 2) & 1, chain & 3, quarter, lane, smf + wid * 1792);
    } else if (wid < 4) {
      const int t2 = task + (wid - 2) * 256;
      scan_s5(p, l, t2 >> 5, (t2 >> 4) & 1, t2 & 15, lane, smf + 9728 + (wid - 2) * 4352);
    } else {
      const int chain = task & 127, quarter = wid - 4;
      if (task < 128) scan_gla<0>(p, l, chain >> 3, (chain >> 2) & 1, chain & 3, quarter, lane, smf + 3584 + quarter * 1536);
      else scan_gla<1>(p, l, chain >> 3, (chain >> 2) & 1, chain & 3, quarter, lane, smf + 3584 + quarter * 1536);
    }
  }
}

DEVINL void phase_post(const Params& p, int l, bool skipctx = false) {
  char* ws = p.ws;
  bf16_t* OUTp = (bf16_t*)(ws + OFF_AR + AR_OUT);
  const bf16_t* PR = (const bf16_t*)(ws + OFF_AR + AR_PREST);
  const bf16_t* RKV = (const bf16_t*)(ws + OFF_AR + AR_RKV);
  const bf16_t* L = (const bf16_t*)(ws + OFF_AR + AR_L);
  const int lane = otid(p.wave) & 63, wid = otid(p.wave) >> 6;
  const int gw = blockIdx.x * 8 + wid, nw = gridDim.x * 8;
  const int c = lane * 4;
  const F4 gn_a = ld4f(p.in[21] + l * 256 + c), ka = ld4f(p.in[19] + l * 256 + c), rk = ld4f(p.in[20] + l * 256 + c);
  const F4 gn_b = ld4f(p.in[22] + l * 256 + c), dsk = ld4f(p.in[30] + l * 256 + c), gn_d = ld4f(p.in[35] + l * 256 + c);
  for (int row = gw; row < MROWS; row += nw) {
    if (skipctx && (row % SEQT) < 256) continue;
    const size_t ro = (size_t)row * 256 + c;
    {
      F4 y0 = ld4bf(OUTp + 0 * OUTSLOT + ro), y1 = ld4bf(OUTp + 4 * OUTSLOT + ro);
      float a0 = y0.a + y1.a, a1 = y0.b + y1.b, a2 = y0.c + y1.c, a3 = y0.d + y1.d;
      float mean = row16_sum(a0 + a1 + a2 + a3) * (1.f / 64.f);
      a0 -= mean; a1 -= mean; a2 -= mean; a3 -= mean;
      float rs = rsqrtf(row16_sum(a0 * a0 + a1 * a1 + a2 * a2 + a3 * a3) * (1.f / 64.f) + 64e-5f);
      F4 r_ = ld4bf(RKV + (size_t)row * 1024 + c), k_ = ld4bf(RKV + (size_t)row * 1024 + 256 + c), v_ = ld4bf(RKV + (size_t)row * 1024 + 512 + c);
      F4 af = ld4bf(L + (size_t)row * 1280 + 512 + c), ab = ld4bf(L + (size_t)row * 1280 + 768 + c), gg = ld4bf(L + (size_t)row * 1280 + 1024 + c);
      float t = r_.a * k_.a * rk.a * (2.f + (af.a + ab.a - 2.f) * ka.a) + r_.b * k_.b * rk.b * (2.f + (af.b + ab.b - 2.f) * ka.b)
              + r_.c * k_.c * rk.c * (2.f + (af.c + ab.c - 2.f) * ka.c) + r_.d * k_.d * rk.d * (2.f + (af.d + ab.d - 2.f) * ka.d);
      float bs = row16_sum(t);
      st4bf(OUTp + 0 * OUTSLOT + ro, (a0 * rs * gn_a.a + bs * v_.a) * gg.a, (a1 * rs * gn_a.b + bs * v_.b) * gg.b,
            (a2 * rs * gn_a.c + bs * v_.c) * gg.c, (a3 * rs * gn_a.d + bs * v_.d) * gg.d);
    }
    {
      F4 y0 = ld4bf(OUTp + 1 * OUTSLOT + ro), y1 = ld4bf(OUTp + 5 * OUTSLOT + ro);
      float a0 = y0.a + y1.a, a1 = y0.b + y1.b, a2 = y0.c + y1.c, a3 = y0.d + y1.d;
      float mean = row16_sum(a0 + a1 + a2 + a3) * (1.f / 64.f);
      a0 -= mean; a1 -= mean; a2 -= mean; a3 -= mean;
      float rs = rsqrtf(row16_sum(a0 * a0 + a1 * a1 + a2 * a2 + a3 * a3) * (1.f / 64.f) + 1e-5f);
      F4 g = ld4bf(PR + (size_t)row * PREST + 768 + c);
      st4bf(OUTp + 1 * OUTSLOT + ro, a0 * rs * gn_b.a * silu(g.a), a1 * rs * gn_b.b * silu(g.b), a2 * rs * gn_b.c * silu(g.c), a3 * rs * gn_b.d * silu(g.d));
    }
    {
      F4 u = ld4bf(PR + (size_t)row * PREST + 1024 + c);
      F4 y0 = ld4bf(OUTp + 8 * OUTSLOT + ro), y1 = ld4bf(OUTp + 7 * OUTSLOT + ro);
      float e0 = dsk.a * u.a + y0.a + y1.a, e1 = dsk.b * u.b + y0.b + y1.b, e2 = dsk.c * u.c + y0.c + y1.c, e3 = dsk.d * u.d + y0.d + y1.d;
      e0 = 0.5f * e0 * (1.f + tanh_fast(0.7978845608028654f * (e0 + 0.044715f * e0 * e0 * e0)));
      e1 = 0.5f * e1 * (1.f + tanh_fast(0.7978845608028654f * (e1 + 0.044715f * e1 * e1 * e1)));
      e2 = 0.5f * e2 * (1.f + tanh_fast(0.7978845608028654f * (e2 + 0.044715f * e2 * e2 * e2)));
      e3 = 0.5f * e3 * (1.f + tanh_fast(0.7978845608028654f * (e3 + 0.044715f * e3 * e3 * e3)));
      st4bf(OUTp + 8 * OUTSLOT + ro, e0, e1, e2, e3);
    }
    {
      F4 y0 = ld4bf(OUTp + 3 * OUTSLOT + ro), y1 = ld4bf(OUTp + 6 * OUTSLOT + ro);
      float a0 = y0.a + y1.a, a1 = y0.b + y1.b, a2 = y0.c + y1.c, a3 = y0.d + y1.d;
      float rs = rsqrtf(row16_sum(a0 * a0 + a1 * a1 + a2 * a2 + a3 * a3) * (1.f / 64.f) + 1e-5f);
      F4 g = ld4bf(PR + (size_t)row * PREST + 2304 + c);
      st4bf(OUTp + 3 * OUTSLOT + ro, a0 * rs * gn_d.a * silu(g.a), a1 * rs * gn_d.b * silu(g.b), a2 * rs * gn_d.c * silu(g.c), a3 * rs * gn_d.d * silu(g.d));
    }
  }
}

__global__ void __launch_bounds__(512, 2) mega(Params p_in) {
  Params p = p_in;
  p.wave = __builtin_amdgcn_readfirstlane((int)threadIdx.x >> 6);
  cg::grid_group grid = cg::this_grid();
  extern __shared__ __attribute__((aligned(16))) unsigned char smem[];
  float* smf = (float*)smem;
  char* ws = p.ws;

  if (p.ws_size < WS_NEED) {
    for (size_t i = (size_t)blockIdx.x * 512 + otid(p.wave); i < (size_t)NB * 2048 * 1024; i += (size_t)gridDim.x * 512)
      p.out[i] = __uint_as_float(0x7fc00000u);
    return;
  }

  unsigned* barw = (unsigned*)(ws + OFF_BAR);
  volatile XLAS unsigned* xst = (volatile XLAS unsigned*)(XLAS unsigned char*)(smem + 131072);
  if (blockIdx.x == 0) for (int i = otid(p.wave); i < XCD_BAR_WORDS; i += 512) barw[i] = 0u;
  if (otid(p.wave) < 4) xst[otid(p.wave)] = 0u;
  phase_ada_partial(p, smf);
  phase_tables(p);
  grid.sync();
  (void)xcd_barrier_post(p.wave, barw, xst);
  phase_ada_reduce(p);
  xcd_barrier(p, smem);

  float* X = (float*)(ws + OFF_X);
  const float* Mod = (const float*)(ws + OFF_MOD);
  bf16_t* HFFN = (bf16_t*)(ws + OFF_AR + AR_HFFN);
  bf16_t* HMIX = (bf16_t*)(ws + OFF_AR + AR_HMIX);
  bf16_t* HP = (bf16_t*)(ws + OFF_AR + AR_HP);
  bf16_t* U = (bf16_t*)(ws + OFF_AR + AR_U);
  bf16_t* OUTp = (bf16_t*)(ws + OFF_AR + AR_OUT);
  bf16_t* BR = (bf16_t*)(ws + OFF_AR + AR_BR);

  for (int l = 0; l < DEPTH; ++l) {
    if (l == 0) phase_lnmod(p, true, false, 0, 0, 0, 0, HFFN, false);
    else phase_lnmod(p, false, true, l - 1, 2, l, 0, HFFN, false);
    const int idle0 = (576 % (int)gridDim.x);
    if (l == 0) { conv_ffn(p, 0, 0, smf, 0, 1408); }
    xcd_barrier(p, smem);
    run_gemm(p.wave, smem, HFFN, (const bf16_t*)(ws + OFF_W13), MROWS, 5632, 1024, EpiSwiglu{U});
    conv_ffn(p, l, 0, smf, 1408, 2112, 3168 % (int)gridDim.x);
    xcd_barrier(p, smem);
    run_gemm(p.wave, smem, U, (const bf16_t*)(ws + OFF_W2), MROWS, 1024, FF, EpiResid{X, Mod, l, 2, 0.5f});
    conv_mix(p, l, smf, idle0);
    xcd_barrier(p, smem);
    phase_lnmod(p, false, true, l, 0, l, 3, HMIX, false);
    xcd_barrier(p, smem);
    run_gemm(p.wave, smem, HMIX, (const bf16_t*)(ws + OFF_WIN), MROWS, 3840, 1024,
             EpiPin{(bf16_t*)(ws + OFF_AR + AR_PRW), (bf16_t*)(ws + OFF_AR + AR_PREST)});
    xcd_barrier(p, smem);
    phase_shift(p, l);
    xcd_barrier(p, smem);
    run_gemm(p.wave, smem, (const bf16_t*)(ws + OFF_AR + AR_A2), (const bf16_t*)(ws + OFF_WL), MROWS, 1280, 384,
             EpiLora{(bf16_t*)(ws + OFF_AR + AR_L), p.in[13] + l * 512, p.in[15] + l * 512});
    xcd_barrier(p, smem);
    phase_scans(p, l, smf);
    xcd_barrier(p, smem);
    const int last = (l == DEPTH - 1);
    phase_post(p, l, last);
    xcd_barrier(p, smem);
    run_gemm(p.wave, smem, OUTp + 8 * OUTSLOT, (const bf16_t*)(ws + OFF_WGLU), MROWS, 256, 256,
             EpiGlu{OUTp + 8 * OUTSLOT, OUTp + 2 * OUTSLOT, p.in[32] + l * 256}, last);
    phase_lnmod(p, false, false, 0, 0, l, 3, HP, false, last);
    xcd_barrier(p, smem);
    run_gemm<EpiBranch, pg8::BranchOrder>(p.wave, smem, OUTp, (const bf16_t*)(ws + OFF_WB), 4 * MROWS, 1024, 256, EpiBranch{BR}, last);
    xcd_barrier(p, smem);
    run_gemm(p.wave, smem, HP, (const bf16_t*)(ws + OFF_WG), MROWS, 4096, 1024, EpiGate{BR, p.in[38] + (size_t)l * 4096}, last);
    xcd_barrier(p, smem);
    run_gemm(p.wave, smem, BR, (const bf16_t*)(ws + OFF_WO4), MROWS, 1024, 4096, EpiResid{X, Mod, l, 5, 1.0f}, last);
    conv_ffn(p, l, 1, smf, 0, 2112, last ? 0 : idle0);
    xcd_barrier(p, smem);
    phase_lnmod(p, false, true, l, 1, l, 6, HFFN, false, last);
    xcd_barrier(p, smem);
    run_gemm(p.wave, smem, HFFN, (const bf16_t*)(ws + OFF_W13), MROWS, 5632, 1024, EpiSwiglu{U}, last);
    xcd_barrier(p, smem);
    run_gemm(p.wave, smem, U, (const bf16_t*)(ws + OFF_W2), MROWS, 1024, FF, EpiResid{X, Mod, l, 8, 0.5f}, last);
    if (l + 1 < DEPTH) conv_ffn(p, l + 1, 0, smf, 0, 1408, idle0);
    xcd_barrier(p, smem);
  }
  phase_lnmod(p, false, true, DEPTH - 1, 2, 0, 0, HFFN, true, true);
}

extern "C" void kernel_launch(void* const* d_in, const int* in_sizes, int n_in, void* d_out, int out_size,
                              void* d_ws, size_t ws_size, hipStream_t stream) {
  static int grid_blocks = 0;
  if (!grid_blocks) {
    int dev = 0, cus = 0, per_cu = 0;
    (void)hipGetDevice(&dev);
    (void)hipDeviceGetAttribute(&cus, hipDeviceAttributeMultiprocessorCount, dev);
    (void)hipFuncSetAttribute((const void*)mega, hipFuncAttributeMaxDynamicSharedMemorySize, LDS_BYTES);
    (void)hipOccupancyMaxActiveBlocksPerMultiprocessor(&per_cu, mega, 512, LDS_BYTES);
    if (per_cu > 1) per_cu = 1;
    if (per_cu < 1) per_cu = 1;
    grid_blocks = cus * per_cu;
  }
  Params p{};
  for (int i = 0; i < 40; ++i) p.in[i] = (const float*)d_in[i];
  p.out = (float*)d_out;
  p.ws = (char*)d_ws;
  p.ws_size = (unsigned long long)ws_size;
  void* args[] = {&p};
  hipError_t e = hipLaunchCooperativeKernel((void*)mega, dim3(grid_blocks), dim3(512), args, LDS_BYTES, stream);
  if (e != hipSuccess) fprintf(stderr, "cooperative launch failed: %s (grid %d)\n", hipGetErrorString(e), grid_blocks);
}
```

```cpp
#include <hip/hip_runtime.h>
#include <hip/hip_cooperative_groups.h>
#include <cstdio>
#include <cstdint>
namespace cg = cooperative_groups;

typedef unsigned short bf16_t;
using bf16x8 = __attribute__((ext_vector_type(8))) short;
using f32x4 = __attribute__((ext_vector_type(4))) float;

#define DEVINL __device__ __forceinline__

constexpr int NB = 16, SEQT = 2304, MROWS = NB * SEQT;
constexpr int D = 1024, FF = 2816, DEPTH = 4;
constexpr int PRW = 1056, PREST = 2560;
constexpr float ALPHA = 1.681792830507429f;
constexpr int LDS_BYTES = 131072 + 256;

constexpr size_t OFF_X = 0;
constexpr size_t OFF_MOD = OFF_X + (size_t)MROWS * 1024 * 4;
constexpr size_t OFF_TAB = OFF_MOD + (size_t)4 * 17 * 9216 * 4;
constexpr size_t OFF_W13 = OFF_TAB + 12288;
constexpr size_t OFF_W2 = OFF_W13 + (size_t)5632 * 1024 * 2;
constexpr size_t OFF_WIN = OFF_W2 + (size_t)1024 * 2816 * 2;
constexpr size_t OFF_WG = OFF_WIN + (size_t)3840 * 1024 * 2;
constexpr size_t OFF_WB = OFF_WG + (size_t)4096 * 1024 * 2;
constexpr size_t OFF_WO4 = OFF_WB + (size_t)4096 * 256 * 2;
constexpr size_t OFF_WL = OFF_WO4 + (size_t)1024 * 4096 * 2;
constexpr size_t OFF_WGLU = OFF_WL + (size_t)1280 * 384 * 2;
constexpr size_t OFF_BAR = OFF_WGLU + (size_t)256 * 256 * 2;
constexpr size_t OFF_AR = OFF_BAR + 16384;
constexpr size_t AR_PREST = 0;
constexpr size_t AR_L = AR_PREST + (size_t)MROWS * PREST * 2;
constexpr size_t AR_RKV = AR_L + (size_t)MROWS * 1280 * 2;
constexpr size_t AR_OUT = AR_RKV + (size_t)MROWS * 1024 * 2;
constexpr size_t AR_END = AR_OUT + (size_t)9 * MROWS * 256 * 2;
constexpr size_t AR_PRW = AR_OUT;
constexpr size_t AR_A2 = AR_OUT + (size_t)MROWS * PRW * 2;
constexpr size_t AR_HFFN = 0;
constexpr size_t AR_U = (size_t)MROWS * 1024 * 2;
constexpr size_t AR_HMIX = AR_L;
constexpr size_t AR_BR = 0;
constexpr size_t AR_MODP = 0;
constexpr size_t WS_NEED = OFF_AR + AR_END;
constexpr size_t OUTSLOT = (size_t)MROWS * 256;
constexpr size_t AR_HP = AR_OUT + 4 * OUTSLOT * 2;
static_assert((size_t)MROWS * 4096 * 2 <= AR_OUT, "Br must not reach the OUT slots");

struct Params {
  const float* in[40];
  float* out;
  char* ws;
  unsigned long long ws_size;
  int wave;
  int pad_;
};

DEVINL int otid(int wave) { int ln; asm volatile("v_mbcnt_lo_u32_b32 %0, -1, 0\n\tv_mbcnt_hi_u32_b32 %0, -1, %0" : "=v"(ln)); return wave * 64 + ln; }
DEVINL bf16_t f2bf(float f) {
  unsigned u = __float_as_uint(f);
  u += 0x7fffu + ((u >> 16) & 1u);
  return (bf16_t)(u >> 16);
}
DEVINL float bf2f(bf16_t h) { return __uint_as_float(((unsigned)h) << 16); }
typedef __bf16 bf16x2_t __attribute__((ext_vector_type(2)));
DEVINL unsigned pk2(float a, float b) { bf16x2_t v = {(__bf16)a, (__bf16)b}; return __builtin_bit_cast(unsigned, v); }
DEVINL float sigm(float x) { return __builtin_amdgcn_rcpf(1.f + __expf(-x)); }
DEVINL float silu(float x) { return x * __builtin_amdgcn_rcpf(1.f + __expf(-x)); }
DEVINL float tanh_fast(float x) { return 1.f - 2.f * __builtin_amdgcn_rcpf(1.f + __expf(2.f * x)); }
DEVINL float wave_sum(float v) {
#pragma unroll
  for (int o = 32; o > 0; o >>= 1) v += __shfl_xor(v, o);
  return v;
}

DEVINL void conv_tile(int wave, bool valid, const float* __restrict__ src, int ldsrc, int k0, int kval, int n0, int nval,
                      bf16_t* dst, int ldd, int dk0, int mode, int which, int drow0, float* sm) {
  const int tid = otid(wave) & 255;
#pragma unroll
  for (int i = 0; i < 16; ++i) {
    int k = i * 4 + (tid >> 6), n = tid & 63;
    float v = 0.f;
    if (valid && src != nullptr && (k0 + k) < kval && (n0 + n) < nval) v = src[(size_t)(k0 + k) * ldsrc + n0 + n];
    sm[k * 65 + n] = v;
  }
  __syncthreads();
  if (valid) {
#pragma unroll
    for (int i = 0; i < 8; ++i) {
      int j = i * 8 + (tid >> 5), kp = tid & 31;
      int n = n0 + j;
      int drow = (mode == 1) ? ((n >> 4) * 32 + which * 16 + (n & 15)) : (drow0 + j);
      unsigned lo = f2bf(sm[(2 * kp) * 65 + j]), hi = f2bf(sm[(2 * kp + 1) * 65 + j]);
      *(unsigned*)(dst + (size_t)drow * ldd + dk0 + 2 * kp) = lo | (hi << 16);
    }
  }
  __syncthreads();
}

DEVINL void conv_ffn(const Params& p, int l, int i, float* smf, int t_lo = 0, int t_hi = 2112, int blk0 = 0) {
  char* ws = p.ws;
  bf16_t* W13 = (bf16_t*)(ws + OFF_W13);
  bf16_t* W2 = (bf16_t*)(ws + OFF_W2);
  const float* w1 = p.in[8] + (size_t)(l * 2 + i) * 1024 * 2816;
  const float* w3 = p.in[9] + (size_t)(l * 2 + i) * 1024 * 2816;
  const float* w2 = p.in[10] + (size_t)(l * 2 + i) * 2816 * 1024;
  const int half = otid(p.wave) >> 8;
  float* sm = smf + half * 4160;
  if ((int)blockIdx.x < blk0) return;
  for (int t0 = t_lo + ((int)blockIdx.x - blk0) * 2; t0 < t_hi; t0 += ((int)gridDim.x - blk0) * 2) {
    int t = t0 + half; bool valid = t < t_hi; if (!valid) t = t_hi - 1;
    if (t < 1408) {
      int which = t >= 704; int tt = t - which * 704;
      int nt_ = tt % 44, kt = tt / 44;
      conv_tile(p.wave, valid, which ? w3 : w1, 2816, kt * 64, 1024, nt_ * 64, 2816, W13, 1024, kt * 64, 1, which, 0, sm);
    } else {
      int tt = t - 1408; int nt_ = tt % 16, kt = tt / 16;
      conv_tile(p.wave, valid, w2, 1024, kt * 64, 2816, nt_ * 64, 1024, W2, 2816, kt * 64, 0, 0, nt_ * 64, sm);
    }
  }
}

DEVINL void conv_mix(const Params& p, int l, float* smf, int blk0 = 0) {
  char* ws = p.ws;
  const int half = otid(p.wave) >> 8;
  float* sm = smf + half * 4160;
  const int T = 3400;
  if ((int)blockIdx.x < blk0) return;
  for (int t0 = ((int)blockIdx.x - blk0) * 2; t0 < T; t0 += ((int)gridDim.x - blk0) * 2) {
    int t = t0 + half; bool valid = t < T; if (!valid) t = T - 1;
    if (t < 960) {
      int nt_ = t % 60, kt = t / 60;
      conv_tile(p.wave, valid, p.in[11] + (size_t)l * 1024 * 3616, 3616, kt * 64, 1024, nt_ * 64, 3616,
                (bf16_t*)(ws + OFF_WIN), 1024, kt * 64, 0, 0, nt_ * 64, sm);
    } else if (t < 1984) {
      int tt = t - 960; int nt_ = tt % 64, kt = tt / 64;
      conv_tile(p.wave, valid, p.in[37] + (size_t)l * 1024 * 4096, 4096, kt * 64, 1024, nt_ * 64, 4096,
                (bf16_t*)(ws + OFF_WG), 1024, kt * 64, 0, 0, nt_ * 64, sm);
    } else if (t < 2240) {
      int tt = t - 1984; int n = tt >> 6; int r = tt & 63; int nt_ = r % 16, kt = r / 16;
      conv_tile(p.wave, valid, p.in[36] + (size_t)(l * 4 + n) * 256 * 1024, 1024, kt * 64, 256, nt_ * 64, 1024,
                (bf16_t*)(ws + OFF_WB) + (size_t)n * 1024 * 256, 256, kt * 64, 0, 0, nt_ * 64, sm);
    } else if (t < 3264) {
      int tt = t - 2240; int rep = tt >> 8; int r = tt & 255; int nt_ = r % 16, kt = r / 16;
      conv_tile(p.wave, valid, p.in[39] + (size_t)l * 1024 * 1024, 1024, kt * 64, 1024, nt_ * 64, 1024,
                (bf16_t*)(ws + OFF_WO4), 4096, rep * 1024 + kt * 64, 0, 0, nt_ * 64, sm);
    } else if (t < 3280) {
      int tt = t - 3264; int nt_ = tt % 4, kt = tt / 4;
      conv_tile(p.wave, valid, p.in[31] + (size_t)l * 256 * 256, 256, kt * 64, 256, nt_ * 64, 256,
                (bf16_t*)(ws + OFF_WGLU), 256, kt * 64, 0, 0, nt_ * 64, sm);
    } else {
      int tt = t - 3280; int nt_ = tt % 20, kt = tt / 20;
      int seg = nt_ >> 2, sub = nt_ & 3;
      const float* s_ = nullptr; int k0 = 0, kval = 0;
      if (seg == 0 && kt == 0) { s_ = p.in[14] + (size_t)(l * 2 + 0) * 64 * 256; kval = 64; }
      else if (seg == 1 && kt == 0) { s_ = p.in[14] + (size_t)(l * 2 + 1) * 64 * 256; kval = 64; }
      else if (seg == 2 && kt == 1) { s_ = p.in[16] + (size_t)(l * 2 + 0) * 64 * 256; kval = 64; }
      else if (seg == 3 && kt == 1) { s_ = p.in[16] + (size_t)(l * 2 + 1) * 64 * 256; kval = 64; }
      else if (seg == 4 && kt >= 2 && kt <= 4) { s_ = p.in[17] + (size_t)l * 160 * 256; k0 = (kt - 2) * 64; kval = 160; }
      conv_tile(p.wave, valid, s_, 256, k0, kval, sub * 64, 256, (bf16_t*)(ws + OFF_WL), 384, kt * 64, 0, 0, nt_ * 64, sm);
    }
  }
}

namespace pg8 {
#define PG8_LAS __attribute__((address_space(3)))
constexpr int BM = 256, BK = 64, HALF = 128, HTB = HALF * BK * 2, STAGE_BYTES = 8 * HTB, NXCD = 8, WGM = 4;
DEVINL int lds_byte(int r, int c) { const int st = (r >> 4) * 2 + (c >> 5), rr = r & 15, cc = c & 31, ob = rr * 64 + cc * 2; return st * 1024 + (ob ^ (((ob >> 9) & 1) << 5)); }
DEVINL void stage_rc(int b, int& R, int& C) { const int st = b / 1024, sb = b % 1024, swz = sb ^ (((sb >> 9) & 1) << 5); R = (st >> 1) * 16 + swz / 64; C = (st & 1) * 32 + (swz % 64) / 2; }
struct Unit { int pm, pn; };
struct Gemm { const bf16_t* A; const bf16_t* Bt; int M, N, K; };
struct StaticOrder {
    int nM, nN, nwg, G, c, skip;
    DEVINL void init(int M, int N, int G_, int c_, int skip_) { nM = M / BM; if (skip_) nM = (nM / 9) * 8; nN = N / BM; nwg = nM * nN; G = G_; c = c_; skip = skip_; }
    DEVINL bool next(int i, Unit& u) const {
        const long Lx = (long)i * G + c; if (Lx >= nwg) return false;
        int wgid = (int)Lx; { const int q = nwg / NXCD, r = nwg % NXCD, xcd = wgid % NXCD, off = wgid / NXCD; wgid = (xcd < r ? xcd * (q + 1) : r * (q + 1) + (xcd - r) * q) + off; }
        const int nig = WGM * nN, gid = wgid / nig, fm = gid * WGM, gsz = (nM - fm) < WGM ? (nM - fm) : WGM;
        u.pm = fm + ((wgid % nig) % gsz); u.pn = (wgid % nig) / gsz;
        if (skip) u.pm = (u.pm >> 3) * 9 + 1 + (u.pm & 7);
        return true;
    }
    DEVINL void a_ready(const Unit&) const {}
    DEVINL void done(const Unit&) const {}
};
struct BranchOrder : StaticOrder {
    DEVINL bool next(int i, Unit& u) const { if (!StaticOrder::next(i, u)) return false; u.pn = (u.pm / 144) * 4 + u.pn; return true; }
};

template <class Epi, class Sched>
DEVINL void gemm_phase(int wave, PG8_LAS unsigned char* lds, const Gemm g, const Sched& S, const Epi& E) {
    const int tid = otid(wave), wid = __builtin_amdgcn_readfirstlane(tid >> 6), lane = tid & 63, wr = wid >> 2, wc = wid & 3, fr = lane & 15, fq = lane >> 4;
    const int K = g.K, nt = K / BK;
    unsigned voffA[2], voffB[2];
#pragma unroll
    for (int i = 0; i < 2; ++i) { int R, C; stage_rc(tid * 16 + i * 8192, R, C);
        voffA[i] = (unsigned)(R * K + C) * 2u; voffB[i] = (unsigned)(R * K + C) * 2u; }
    const size_t kstep = (size_t)(BK * 2);
    const size_t hstep = (size_t)HALF * K * 2;
    const size_t tstep = 2 * hstep;
    const unsigned ldsw = (unsigned)wid * 1024u;
    const int aoff = lds_byte(wr * 64 + fr, fq * 8), boff = lds_byte(wc * 32 + fr, fq * 8);
#define PG8_SA(b, h) (((b) * 2 + (h)) * HTB)
#define PG8_SB(b, h) ((4 + (b) * 2 + (h)) * HTB)
#define PG8_STAGE(bufoff, gbase, voff) do { _Pragma("unroll") for (int _i = 0; _i < 2; ++_i) \
        __builtin_amdgcn_global_load_lds((const unsigned*)((const char*)(gbase) + (voff)[_i]), (PG8_LAS unsigned*)(lds + (bufoff) + ldsw + _i * 8192), 16, 0, 0); } while (0)
#define PG8_LDA(dst, b, h) do { _Pragma("unroll") for (int m = 0; m < 4; ++m) _Pragma("unroll") for (int k = 0; k < 2; ++k) dst[m][k] = *(const PG8_LAS bf16x8*)(lds + PG8_SA(b, h) + aoff + m * 2048 + k * 1024); } while (0)
#define PG8_LDB(dst, b, h) do { _Pragma("unroll") for (int n = 0; n < 2; ++n) _Pragma("unroll") for (int k = 0; k < 2; ++k) dst[n][k] = *(const PG8_LAS bf16x8*)(lds + PG8_SB(b, h) + boff + n * 2048 + k * 1024); } while (0)
#define PG8_MMA(ai, bj, At, Bt) do { __builtin_amdgcn_s_setprio(1); _Pragma("unroll") for (int m = 0; m < 4; ++m) _Pragma("unroll") for (int n = 0; n < 2; ++n) _Pragma("unroll") for (int k = 0; k < 2; ++k) \
        acc[ai][bj][m][n] = __builtin_amdgcn_mfma_f32_16x16x32_bf16(Bt[n][k], At[m][k], acc[ai][bj][m][n], 0, 0, 0); __builtin_amdgcn_s_setprio(0); } while (0)
#define PG8_WAIT_V(n) asm volatile("s_waitcnt vmcnt(" #n ")" ::: "memory")
#define PG8_WAIT_L(n) asm volatile("s_waitcnt lgkmcnt(" #n ")" ::: "memory")
#define PG8_BAR __builtin_amdgcn_s_barrier()
#define PG8_SCHED __builtin_amdgcn_sched_barrier(0)
    Unit cur, nxt; int ui = 0;
    if (!S.next(0, cur)) return;
    f32x4 acc[2][2][4][2];
#pragma unroll
    for (int a = 0; a < 2; ++a)
#pragma unroll
        for (int b = 0; b < 2; ++b)
#pragma unroll
            for (int m = 0; m < 4; ++m)
#pragma unroll
                for (int n = 0; n < 2; ++n) acc[a][b][m][n] = (f32x4){0.f, 0.f, 0.f, 0.f};
    bf16x8 At[4][2], B0[2][2], B1[2][2];
    const char* cA = (const char*)g.A + (size_t)cur.pm * tstep; const char* cB = (const char*)g.Bt + (size_t)cur.pn * tstep;
    S.a_ready(cur);
    PG8_STAGE(PG8_SB(0, 0), cB, voffB); PG8_STAGE(PG8_SA(0, 0), cA, voffA); PG8_STAGE(PG8_SB(0, 1), cB + hstep, voffB); PG8_STAGE(PG8_SA(0, 1), cA + hstep, voffA);
    if (wr == 1) PG8_BAR;
    PG8_WAIT_V(4); PG8_BAR;
    PG8_STAGE(PG8_SB(1, 0), cB + kstep, voffB); PG8_STAGE(PG8_SA(1, 0), cA + kstep, voffA); PG8_STAGE(PG8_SB(1, 1), cB + hstep + kstep, voffB);
    PG8_WAIT_V(6); PG8_BAR;
    for (;;) {
        const bool has_next = S.next(ui + 1, nxt);
        const char* nA = has_next ? (const char*)g.A + (size_t)nxt.pm * tstep : cA; const char* nB = has_next ? (const char*)g.Bt + (size_t)nxt.pn * tstep : cB;
        for (int t = 0; t < nt; t += 2) {
            const bool last = (t == nt - 2);
            const char* a1 = cA + (size_t)(t + 1) * kstep;
            const char* a2 = last ? nA : cA + (size_t)(t + 2) * kstep; const char* b2 = last ? nB : cB + (size_t)(t + 2) * kstep;
            const char* a3 = a2 + kstep; const char* b3 = b2 + kstep;
            if (last && has_next) S.a_ready(nxt);
            PG8_LDB(B0, 0, 0); PG8_SCHED; PG8_LDA(At, 0, 0); PG8_STAGE(PG8_SA(1, 1), a1 + hstep, voffA);
            PG8_WAIT_L(8); PG8_BAR; PG8_WAIT_L(0); PG8_MMA(0, 0, At, B0); PG8_BAR; PG8_SCHED;
            PG8_LDB(B1, 0, 1); PG8_STAGE(PG8_SB(0, 0), b2, voffB);
            PG8_BAR; PG8_WAIT_L(0); PG8_MMA(0, 1, At, B1); PG8_BAR;
            PG8_LDA(At, 0, 1); PG8_STAGE(PG8_SA(0, 0), a2, voffA);
            PG8_BAR; PG8_WAIT_L(0); PG8_MMA(1, 0, At, B0); PG8_BAR; PG8_SCHED;
            PG8_STAGE(PG8_SB(0, 1), b2 + hstep, voffB);
            PG8_WAIT_V(6); PG8_BAR; PG8_MMA(1, 1, At, B1); PG8_BAR;
            PG8_LDB(B0, 1, 0); PG8_SCHED; PG8_LDA(At, 1, 0); PG8_STAGE(PG8_SA(0, 1), a2 + hstep, voffA);
            PG8_WAIT_L(8); PG8_BAR; PG8_WAIT_L(0); PG8_MMA(0, 0, At, B0); PG8_BAR; PG8_SCHED;
            PG8_LDB(B1, 1, 1); PG8_STAGE(PG8_SB(1, 0), b3, voffB);
            PG8_BAR; PG8_WAIT_L(0); PG8_MMA(0, 1, At, B1); PG8_BAR;
            PG8_LDA(At, 1, 1); PG8_STAGE(PG8_SA(1, 0), a3, voffA);
            PG8_BAR; PG8_WAIT_L(0); PG8_MMA(1, 0, At, B0); PG8_BAR; PG8_SCHED;
            PG8_STAGE(PG8_SB(1, 1), b3 + hstep, voffB);
            PG8_WAIT_V(6); PG8_BAR; PG8_MMA(1, 1, At, B1); PG8_BAR;
        }
        E(acc, cur, wr, wc, fr, fq); S.done(cur);
        if (!has_next) break;
#pragma unroll
        for (int a = 0; a < 2; ++a)
#pragma unroll
            for (int b = 0; b < 2; ++b)
#pragma unroll
                for (int m = 0; m < 4; ++m)
#pragma unroll
                    for (int n = 0; n < 2; ++n) acc[a][b][m][n] = (f32x4){0.f, 0.f, 0.f, 0.f};
        cur = nxt; cA = nA; cB = nB; ++ui;
    }
    PG8_WAIT_V(0);
    if (wr == 0) PG8_BAR;
    PG8_BAR;
#undef PG8_SA
#undef PG8_SB
#undef PG8_STAGE
#undef PG8_LDA
#undef PG8_LDB
#undef PG8_MMA
#undef PG8_WAIT_V
#undef PG8_WAIT_L
#undef PG8_BAR
#undef PG8_SCHED
}
}

using AccT = f32x4[2][2][4][2];
#define EPI_ROWS_BEGIN                                                                     \
  _Pragma("unroll") for (int ai = 0; ai < 2; ++ai) _Pragma("unroll") for (int m = 0; m < 4; ++m) { \
    const int row = rowbase + ai * 128 + m * 16;
#define EPI_ROWS_END }

#define EPI_RLOOP _Pragma("unroll") for (int ai = 0; ai < 2; ++ai) _Pragma("unroll") for (int m = 0; m < 4; ++m)
#define EPI_CLOOP _Pragma("unroll") for (int bj = 0; bj < 2; ++bj) _Pragma("unroll") for (int n = 0; n < 2; ++n)
struct EpiSwiglu {
  static constexpr bool PERM = false, AFTER_DRAIN = false;
  bf16_t* U;
  DEVINL void operator()(const AccT& acc, const pg8::Unit& u, int wr, int wc, int fr, int fq) const {
    const int rowbase = u.pm * 256 + wr * 64 + fr;
#pragma unroll
    for (int bj = 0; bj < 2; ++bj) {
      const int ucol = ((u.pn * 256 + bj * 128 + wc * 32) >> 5) * 16 + 4 * fq;
      EPI_RLOOP {
        const int row = rowbase + ai * 128 + m * 16;
        f32x4 a = acc[ai][bj][m][0], b = acc[ai][bj][m][1];
        uint2 pk; pk.x = pk2(silu(a[0]) * b[0], silu(a[1]) * b[1]); pk.y = pk2(silu(a[2]) * b[2], silu(a[3]) * b[3]);
        *(uint2*)(U + (size_t)row * FF + ucol) = pk;
      }
    }
  }
};
struct EpiResid {
  static constexpr bool PERM = false, AFTER_DRAIN = false;
  float* X; const float* Mod; int ml, mj; float gs;
  DEVINL void operator()(const AccT& acc, const pg8::Unit& u, int wr, int wc, int fr, int fq) const {
    const int rowbase = u.pm * 256 + wr * 64 + fr;
    const int bq = u.pm / 9, mr = (u.pm - bq * 9 == 0) ? 16 : bq;
    const float* gv = Mod + (size_t)(ml * 17 + mr) * 9216 + mj * 1024;
    EPI_CLOOP {
      const int col = u.pn * 256 + bj * 128 + wc * 32 + n * 16 + 4 * fq;
      const f32x4 g4 = *(const f32x4*)(gv + col) * gs;
      EPI_RLOOP {
        const int row = rowbase + ai * 128 + m * 16;
        float* xp = X + (size_t)row * 1024 + col;
        f32x4 x = *(const f32x4*)xp;
        *(f32x4*)xp = x * ALPHA + g4 * acc[ai][bj][m][n];
        if (m & 1) __builtin_amdgcn_sched_barrier(0);
      }
    }
  }
};
struct EpiPin {
  static constexpr bool PERM = false, AFTER_DRAIN = false;
  bf16_t* PRWp; bf16_t* PRp;
  DEVINL void operator()(const AccT& acc, const pg8::Unit& u, int wr, int wc, int fr, int fq) const {
    const int rowbase = u.pm * 256 + wr * 64 + fr;
    EPI_CLOOP {
      const int col = u.pn * 256 + bj * 128 + wc * 32 + n * 16 + 4 * fq;
      EPI_RLOOP {
        const int row = rowbase + ai * 128 + m * 16;
        f32x4 v = acc[ai][bj][m][n];
        uint2 pk; pk.x = pk2(v[0], v[1]); pk.y = pk2(v[2], v[3]);
        if (col < PRW) *(uint2*)(PRWp + (size_t)row * PRW + col) = pk;
        else if (col < 3616) *(uint2*)(PRp + (size_t)row * PREST + (col - PRW)) = pk;
      }
    }
  }
};
struct EpiLora {
  static constexpr bool PERM = false, AFTER_DRAIN = false;
  bf16_t* Lo; const float* w0; const float* a0;
  DEVINL void operator()(const AccT& acc, const pg8::Unit& u, int wr, int wc, int fr, int fq) const {
    const int rowbase = u.pm * 256 + wr * 64 + fr;
    EPI_CLOOP {
      const int col = u.pn * 256 + bj * 128 + wc * 32 + n * 16 + 4 * fq;
      f32x4 b4 = (f32x4){0.f, 0.f, 0.f, 0.f};
      if (u.pn < 2) b4 = *(const f32x4*)(w0 + col);
      else if (u.pn < 4) b4 = *(const f32x4*)(a0 + (col - 512));
      EPI_RLOOP {
        const int row = rowbase + ai * 128 + m * 16;
        f32x4 v = acc[ai][bj][m][n] + b4;
        if (u.pn < 2) {
#pragma unroll
          for (int i = 0; i < 4; ++i) v[i] = 1.f - __expf(-0.6065306597126334f * sigm(v[i]));
        } else if (u.pn < 4) {
#pragma unroll
          for (int i = 0; i < 4; ++i) v[i] = sigm(v[i]);
        }
        uint2 pk; pk.x = pk2(v[0], v[1]); pk.y = pk2(v[2], v[3]);
        *(uint2*)(Lo + (size_t)row * 1280 + col) = pk;
      }
    }
  }
};
struct EpiGlu {
  static constexpr bool PERM = false, AFTER_DRAIN = false;
  const bf16_t* Yin; bf16_t* Yc; const float* bg;
  DEVINL void operator()(const AccT& acc, const pg8::Unit& u, int wr, int wc, int fr, int fq) const {
    const int rowbase = u.pm * 256 + wr * 64 + fr;
    EPI_CLOOP {
      const int col = bj * 128 + wc * 32 + n * 16 + 4 * fq;
      const f32x4 b4 = *(const f32x4*)(bg + col);
      EPI_RLOOP {
        const int row = rowbase + ai * 128 + m * 16;
        uint2 yr = *(const uint2*)(Yin + (size_t)row * 256 + col);
        f32x4 v = acc[ai][bj][m][n] + b4;
        float y0 = bf2f((bf16_t)(yr.x & 0xffff)), y1 = bf2f((bf16_t)(yr.x >> 16)), y2 = bf2f((bf16_t)(yr.y & 0xffff)), y3 = bf2f((bf16_t)(yr.y >> 16));
        uint2 pk; pk.x = pk2(y0 * sigm(v[0]), y1 * sigm(v[1])); pk.y = pk2(y2 * sigm(v[2]), y3 * sigm(v[3]));
        *(uint2*)(Yc + (size_t)row * 256 + col) = pk;
      }
    }
  }
};
struct EpiBranch {
  static constexpr bool PERM = false, AFTER_DRAIN = false;
  bf16_t* Br;
  DEVINL void operator()(const AccT& acc, const pg8::Unit& u, int wr, int wc, int fr, int fq) const {
    const int nb = u.pm / 144, pmr = u.pm - nb * 144;
    const int rowbase = pmr * 256 + wr * 64 + fr;
    EPI_CLOOP {
      const int col = u.pn * 256 + bj * 128 + wc * 32 + n * 16 + 4 * fq;
      EPI_RLOOP {
        const int row = rowbase + ai * 128 + m * 16;
        f32x4 v = acc[ai][bj][m][n];
        uint2 pk; pk.x = pk2(v[0], v[1]); pk.y = pk2(v[2], v[3]);
        *(uint2*)(Br + (size_t)row * 4096 + col) = pk;
      }
    }
  }
};
struct EpiGate {
  static constexpr bool PERM = false, AFTER_DRAIN = false;
  bf16_t* Br; const float* bgate;
  DEVINL void operator()(const AccT& acc, const pg8::Unit& u, int wr, int wc, int fr, int fq) const {
    const int rowbase = u.pm * 256 + wr * 64 + fr;
    EPI_CLOOP {
      const int col = u.pn * 256 + bj * 128 + wc * 32 + n * 16 + 4 * fq;
      const f32x4 b4 = *(const f32x4*)(bgate + col);
      EPI_RLOOP {
        const int row = rowbase + ai * 128 + m * 16;
        bf16_t* bp = Br + (size_t)row * 4096 + col;
        uint2 br = *(const uint2*)bp;
        f32x4 v = acc[ai][bj][m][n] + b4;
        float y0 = bf2f((bf16_t)(br.x & 0xffff)), y1 = bf2f((bf16_t)(br.x >> 16)), y2 = bf2f((bf16_t)(br.y & 0xffff)), y3 = bf2f((bf16_t)(br.y >> 16));
        uint2 pk; pk.x = pk2(y0 * sigm(v[0]), y1 * sigm(v[1])); pk.y = pk2(y2 * sigm(v[2]), y3 * sigm(v[3]));
        *(uint2*)bp = pk;
      }
    }
  }
};

template <class Epi, class Order = pg8::StaticOrder>
DEVINL void run_gemm(int wave, unsigned char* smem, const bf16_t* A, const bf16_t* Bt, int Mo, int N, int K, const Epi& E, int skip = 0) {
  asm volatile("" : "+s"(K), "+s"(N), "+s"(Mo));
  Order S; S.init(Mo, N, gridDim.x, blockIdx.x, skip);
  pg8::gemm_phase<Epi, Order>(wave, (PG8_LAS unsigned char*)smem, pg8::Gemm{A, Bt, Mo, N, K}, S, E);
}

#define XB_TMO      128
#define XB_XCNT(j)  (256  + 64 * (j))
#define XB_XSUB(j)  (1280 + 64 * (j))
#define XB_XGEN(j)  (2304 + 64 * (j))
#define XB_TOP      3328
#define XB_TOPGEN   3392
#define XCD_BAR_WORDS 3456
#define XB_SPIN_CAP (1u << 18)
#define XLAS __attribute__((address_space(3)))
DEVINL unsigned xb_ld(unsigned* p)              { return __hip_atomic_load(p, __ATOMIC_RELAXED, __HIP_MEMORY_SCOPE_AGENT); }
DEVINL unsigned xb_add(unsigned* p, unsigned v) { return __hip_atomic_fetch_add(p, v, __ATOMIC_RELAXED, __HIP_MEMORY_SCOPE_AGENT); }
DEVINL unsigned xb_xcc_id() { return (unsigned)__builtin_amdgcn_s_getreg((3 << 11) | 20) & 0xFu; }
#define XB_SPIN(cond, bar) do { unsigned _sp = 0; while (cond) { __builtin_amdgcn_s_sleep(1); \
    if ((++_sp & 255u) == 0u) { if (xb_ld(&(bar)[XB_TMO])) break; if (_sp > XB_SPIN_CAP) { atomicAdd(&(bar)[XB_TMO], 1u); break; } } } } while (0)
struct XcdBarrier { unsigned* bar; unsigned x; volatile XLAS unsigned* st; int wave; };
DEVINL XcdBarrier xcd_barrier_post(int wave, unsigned* bar, volatile XLAS unsigned* st) {
    XcdBarrier b; b.bar = bar; b.x = xb_xcc_id(); b.st = st; b.wave = wave;
    if (otid(wave) == 0) (void)xb_add(&bar[XB_XCNT(b.x)], 1u);
    return b;
}
DEVINL void xcd_barrier_complete(unsigned* bar, unsigned x, unsigned& nloc, unsigned& nx) {
    const unsigned G = gridDim.x * gridDim.y * gridDim.z;
    unsigned sum, cnt, mine, sp = 0u;
    for (;;) {
        sum = 0u; cnt = 0u; mine = 0u;
#pragma unroll
        for (unsigned j = 0; j < 16; ++j) { const unsigned c = xb_ld(&bar[XB_XCNT(j)]); sum += c; cnt += (c > 0u) ? 1u : 0u; mine = (j == x) ? c : mine; }
        if (sum == G) break;
        __builtin_amdgcn_s_sleep(1);
        if ((++sp & 255u) == 0u) { if (xb_ld(&bar[XB_TMO])) break; if (sp > XB_SPIN_CAP) { atomicAdd(&bar[XB_TMO], 1u); break; } }
    }
    nloc = mine > 0u ? mine : 1u; nx = cnt > 0u ? cnt : 1u;
}
DEVINL void xcd_barrier(const Params& p, unsigned char* smem) {
    XcdBarrier b; b.bar = (unsigned*)(p.ws + OFF_BAR); b.x = xb_xcc_id(); b.st = (volatile XLAS unsigned*)(XLAS unsigned char*)(smem + 131072); b.wave = p.wave;
    asm volatile("s_waitcnt vmcnt(0)" ::: "memory");
    __syncthreads();
    if (otid(b.wave) == 0) {
        unsigned* bar = b.bar;
        __builtin_amdgcn_s_waitcnt(0);
        unsigned nloc = b.st[0], nx = b.st[1];
        if (nloc == 0u) { xcd_barrier_complete(bar, b.x, nloc, nx); b.st[0] = nloc; b.st[1] = nx; }
        const unsigned old = xb_add(&bar[XB_XSUB(b.x)], 1u);
        const unsigned gen = old / nloc;
        if (old + 1u == (gen + 1u) * nloc) {
            __builtin_amdgcn_fence(__ATOMIC_RELEASE, "agent");
            asm volatile("s_waitcnt vmcnt(0)" ::: "memory");
            const unsigned og = xb_add(&bar[XB_TOP], 1u);
            const unsigned tg = og / nx;
            if (og + 1u == (tg + 1u) * nx) xb_add(&bar[XB_TOPGEN], 1u);
            else XB_SPIN(xb_ld(&bar[XB_TOPGEN]) == tg, bar);
            __builtin_amdgcn_fence(__ATOMIC_ACQUIRE, "agent");
            xb_add(&bar[XB_XGEN(b.x)], 1u);
            asm volatile("s_waitcnt vmcnt(0)" ::: "memory");
        } else {
            XB_SPIN(xb_ld(&bar[XB_XGEN(b.x)]) == gen, bar);
            __builtin_amdgcn_fence(__ATOMIC_ACQUIRE, "agent");
            asm volatile("s_waitcnt vmcnt(0)" ::: "memory");
        }
    }
    __syncthreads();
}

DEVINL void phase_lnmod(const Params& p, bool from_input, bool do_ln, int lnl, int lnj, int ml, int mj,
                        bf16_t* H, bool final_out, bool skipctx = false) {
  char* ws = p.ws;
  float* X = (float*)(ws + OFF_X);
  const float* Mod = (const float*)(ws + OFF_MOD);
  const int lane = otid(p.wave) & 63, wid = otid(p.wave) >> 6;
  const int gw = blockIdx.x * 8 + wid, nw = gridDim.x * 8;
  const float* g = p.in[6] + (size_t)(lnl * 3 + lnj) * 1024;
  const float* bb = p.in[7] + (size_t)(lnl * 3 + lnj) * 1024;
  for (int row0 = gw; row0 < MROWS; row0 += 2 * nw) {
    float4 v[2][4];
    bool ok[2]; int rb[2], rpos[2];
#pragma unroll
    for (int r = 0; r < 2; ++r) {
      const int row = row0 + r * nw;
      ok[r] = row < MROWS;
      rb[r] = row / SEQT; rpos[r] = row - rb[r] * SEQT;
      if (skipctx && rpos[r] < 256) ok[r] = false;
      if (ok[r]) {
        const float* src;
        if (from_input) src = (rpos[r] < 256) ? (p.in[2] + (size_t)(rb[r] * 256 + rpos[r]) * 1024) : (p.in[0] + (size_t)(rb[r] * 2048 + rpos[r] - 256) * 1024);
        else src = X + (size_t)row * 1024;
#pragma unroll
        for (int i = 0; i < 4; ++i) v[r][i] = *(const float4*)(src + i * 256 + lane * 4);
      } else {
#pragma unroll
        for (int i = 0; i < 4; ++i) v[r][i] = make_float4(0.f, 0.f, 0.f, 0.f);
      }
    }
#pragma unroll
    for (int r = 0; r < 2; ++r) {
      if (!ok[r]) continue;
      const int row = row0 + r * nw;
      const int b = rb[r], pos = rpos[r];
      const int mr = pos < 256 ? 16 : b;
      if (do_ln) {
        float s = 0.f;
#pragma unroll
        for (int i = 0; i < 4; ++i) s += v[r][i].x + v[r][i].y + v[r][i].z + v[r][i].w;
        float mean = wave_sum(s) * (1.f / 1024.f);
        float q = 0.f;
#pragma unroll
        for (int i = 0; i < 4; ++i) {
          v[r][i].x -= mean; v[r][i].y -= mean; v[r][i].z -= mean; v[r][i].w -= mean;
          q += v[r][i].x * v[r][i].x + v[r][i].y * v[r][i].y + v[r][i].z * v[r][i].z + v[r][i].w * v[r][i].w;
        }
        float rs = rsqrtf(wave_sum(q) * (1.f / 1024.f) + 1e-5f);
#pragma unroll
        for (int i = 0; i < 4; ++i) {
          float4 gg = *(const float4*)(g + i * 256 + lane * 4);
          float4 b4 = *(const float4*)(bb + i * 256 + lane * 4);
          v[r][i].x = v[r][i].x * rs * gg.x + b4.x; v[r][i].y = v[r][i].y * rs * gg.y + b4.y;
          v[r][i].z = v[r][i].z * rs * gg.z + b4.z; v[r][i].w = v[r][i].w * rs * gg.w + b4.w;
        }
      }
      if (final_out) {
        if (pos >= 256) {
          float* o = p.out + (size_t)(b * 2048 + pos - 256) * 1024;
#pragma unroll
          for (int i = 0; i < 4; ++i) *(float4*)(o + i * 256 + lane * 4) = v[r][i];
        }
      } else {
        const float* sh = Mod + (size_t)(ml * 17 + mr) * 9216 + mj * 1024;
        const float* sc = sh + 1024;
#pragma unroll
        for (int i = 0; i < 4; ++i) {
          if (from_input || do_ln) *(float4*)(X + (size_t)row * 1024 + i * 256 + lane * 4) = v[r][i];
          float4 s4 = *(const float4*)(sh + i * 256 + lane * 4);
          float4 c4 = *(const float4*)(sc + i * 256 + lane * 4);
          uint2 pk;
          pk.x = pk2(v[r][i].x * (1.f + c4.x) + s4.x, v[r][i].y * (1.f + c4.y) + s4.y);
          pk.y = pk2(v[r][i].z * (1.f + c4.z) + s4.z, v[r][i].w * (1.f + c4.w) + s4.w);
          *(uint2*)(H + (size_t)row * 1024 + i * 256 + lane * 4) = pk;
        }
      }
    }
  }
}

DEVINL void phase_ada_partial(const Params& p, float* smf) {
  float* MODP = (float*)(p.ws + OFF_AR + AR_MODP);
  const int tid = otid(p.wave) & 255, half = otid(p.wave) >> 8;
  float* sm = smf + half * 5120;
  for (int it0 = blockIdx.x * 2; it0 < 576; it0 += gridDim.x * 2) {
    int it = it0 + half; bool valid = it < 576; if (!valid) it = 575;
    int kq = it & 3, cb = it >> 2;
    int col = cb * 256 + tid;
    int l = col / 9216, n = col - l * 9216;
    for (int idx = tid; idx < 256 * 17; idx += 256) {
      int r = idx >> 8, k = idx & 255;
      float val = (r < 16) ? p.in[1][r * 1024 + kq * 256 + k] : p.in[3][kq * 256 + k];
      sm[k * 20 + r] = silu(val);
    }
    __syncthreads();
    float acc[17];
#pragma unroll
    for (int r = 0; r < 17; ++r) acc[r] = 0.f;
    const float* w = p.in[4] + ((size_t)l * 1024 + kq * 256) * 9216 + n;
#pragma unroll 4
    for (int k = 0; k < 256; ++k) {
      float wv = w[(size_t)k * 9216];
      const float4* s4 = (const float4*)(sm + k * 20);
      float4 a0 = s4[0], a1 = s4[1], a2 = s4[2], a3 = s4[3];
      float a16 = sm[k * 20 + 16];
      acc[0] += a0.x * wv; acc[1] += a0.y * wv; acc[2] += a0.z * wv; acc[3] += a0.w * wv;
      acc[4] += a1.x * wv; acc[5] += a1.y * wv; acc[6] += a1.z * wv; acc[7] += a1.w * wv;
      acc[8] += a2.x * wv; acc[9] += a2.y * wv; acc[10] += a2.z * wv; acc[11] += a2.w * wv;
      acc[12] += a3.x * wv; acc[13] += a3.y * wv; acc[14] += a3.z * wv; acc[15] += a3.w * wv;
      acc[16] += a16 * wv;
    }
    if (valid) {
#pragma unroll
      for (int r = 0; r < 17; ++r) MODP[((size_t)(kq * 4 + l) * 17 + r) * 9216 + n] = acc[r];
    }
    __syncthreads();
  }
}

DEVINL void phase_ada_reduce(const Params& p) {
  const float* MODP = (const float*)(p.ws + OFF_AR + AR_MODP);
  float* Mod = (float*)(p.ws + OFF_MOD);
  const int total = 4 * 17 * 9216;
  for (int idx = blockIdx.x * 512 + otid(p.wave); idx < total; idx += gridDim.x * 512) {
    int n = idx % 9216; int l = idx / (17 * 9216);
    float s = p.in[5][l * 9216 + n];
#pragma unroll
    for (int kq = 0; kq < 4; ++kq) s += MODP[(size_t)kq * total + idx];
    Mod[idx] = s;
  }
}

DEVINL void phase_tables(const Params& p) {
  float* TAB = (float*)(p.ws + OFF_TAB);
  int idx = blockIdx.x * 512 + otid(p.wave);
  if (idx < 1024) {
    int n = idx >> 4, j = idx & 15;
    float inv = powf(10000.f, -(float)j / 16.f);
    float ang = (float)n * inv;
    TAB[idx] = cosf(ang);
    TAB[1024 + idx] = sinf(ang);
  } else if (idx < 1280) {
    int c = idx - 1024;
    const float* lg = p.in[33];
    float v0 = lg[c], v1 = lg[256 + c], v2 = lg[512 + c], v3 = lg[768 + c];
    float mx = fmaxf(fmaxf(v0, v1), fmaxf(v2, v3));
    float e0 = expf(v0 - mx), e1 = expf(v1 - mx), e2 = expf(v2 - mx), e3 = expf(v3 - mx);
    float inv = 1.f / (e0 + e1 + e2 + e3);
    float s0 = e0 * inv, s1 = e1 * inv, s2 = e2 * inv, s3 = e3 * inv;
    float c0 = s0, c1 = c0 + s1, c2 = c1 + s2, c3 = c2 + s3;
    TAB[2048 + c] = c0 - s0;
    TAB[2048 + 256 + c] = c1 - s0;
    TAB[2048 + 512 + c] = c2 - s0;
    TAB[2048 + 768 + c] = c3 - s0;
  }
}


struct F4 { float a, b, c, d; };
DEVINL F4 ld4bf(const bf16_t* p) { uint2 r = *(const uint2*)p; F4 o; o.a = __uint_as_float(r.x << 16); o.b = __uint_as_float(r.x & 0xffff0000u); o.c = __uint_as_float(r.y << 16); o.d = __uint_as_float(r.y & 0xffff0000u); return o; }
DEVINL void st4bf(bf16_t* p, float a, float b, float c, float d) { uint2 r; r.x = pk2(a, b); r.y = pk2(c, d); *(uint2*)p = r; }
DEVINL F4 ld4f(const float* p) { float4 r = *(const float4*)p; F4 o; o.a = r.x; o.b = r.y; o.c = r.z; o.d = r.w; return o; }
DEVINL float row16_sum(float x) {
  x += __int_as_float(__builtin_amdgcn_update_dpp(0, __float_as_int(x), 0xB1, 0xF, 0xF, true));
  x += __int_as_float(__builtin_amdgcn_update_dpp(0, __float_as_int(x), 0x4E, 0xF, 0xF, true));
  x += __int_as_float(__builtin_amdgcn_update_dpp(0, __float_as_int(x), 0x141, 0xF, 0xF, true));
  x += __int_as_float(__builtin_amdgcn_update_dpp(0, __float_as_int(x), 0x140, 0xF, 0xF, true));
  return x;
}
DEVINL void phase_shift(const Params& p, int l) {
  char* ws = p.ws;
  const bf16_t* PRWp = (const bf16_t*)(ws + OFF_AR + AR_PRW);
  bf16_t* RKV = (bf16_t*)(ws + OFF_AR + AR_RKV);
  bf16_t* A2 = (bf16_t*)(ws + OFF_AR + AR_A2);
  const float* mu = p.in[12] + (size_t)l * PRW;
  bf16_t* PRp = (bf16_t*)(ws + OFF_AR + AR_PREST);
  const float* TABp = (const float*)(ws + OFF_TAB);
  const int lane = otid(p.wave) & 63, wid = otid(p.wave) >> 6;
  const int gw = blockIdx.x * 8 + wid, nw = gridDim.x * 8;
  const int c4 = lane * 4;
  for (int row = gw; row < MROWS; row += nw) {
    int b = row / SEQT, pos = row - b * SEQT;
    const bool hasp = !(pos == 0 || pos == 256);
    const bool hasn = !(pos == 255 || pos == 2303);
    const bf16_t* pr = PRWp + (size_t)row * PRW;
#pragma unroll
    for (int it = 0; it < 5; ++it) {
      const int c = it * 256 + c4;
      if (it < 4 || lane < 8) {
        F4 x0 = ld4bf(pr + c);
        F4 xp = {0.f, 0.f, 0.f, 0.f}, xn = {0.f, 0.f, 0.f, 0.f};
        if (hasp) xp = ld4bf(pr + c - PRW);
        if (hasn) xn = ld4bf(pr + c + PRW);
        F4 m = ld4f(mu + c);
        float s0 = x0.a + m.a * (0.5f * (xp.a + xn.a) - x0.a);
        float s1 = x0.b + m.b * (0.5f * (xp.b + xn.b) - x0.b);
        float s2 = x0.c + m.c * (0.5f * (xp.c + xn.c) - x0.c);
        float s3 = x0.d + m.d * (0.5f * (xp.d + xn.d) - x0.d);
        if (it < 3) {
          st4bf(RKV + (size_t)row * 1024 + c, s0, s1, s2, s3);
          if (it == 1) {
            F4 kc = ld4f(p.in[18] + l * 256 + (c - 256));
            float k0 = s0 * kc.a, k1 = s1 * kc.b, k2 = s2 * kc.c, k3 = s3 * kc.d;
            float nrm = row16_sum(k0 * k0 + k1 * k1 + k2 * k2 + k3 * k3);
            float rs = rsqrtf(fmaxf(nrm, 1e-12f));
            st4bf(RKV + (size_t)row * 1024 + 512 + c, k0 * rs, k1 * rs, k2 * rs, k3 * rs);
          }
        } else if (c < 832) st4bf(A2 + (size_t)row * 384 + (c - 768), tanh_fast(s0), tanh_fast(s1), tanh_fast(s2), tanh_fast(s3));
        else if (c < 896) st4bf(A2 + (size_t)row * 384 + (c - 768), s0, s1, s2, s3);
        else st4bf(A2 + (size_t)row * 384 + 128 + (c - 896), sigm(s0), sigm(s1), sigm(s2), sigm(s3));
      }
    }
    if (lane < 24) *(uint2*)(A2 + (size_t)row * 384 + 288 + c4) = make_uint2(0u, 0u);
    {
      bf16_t* prr = PRp + (size_t)row * PREST;
      const int d = c4 & 63, jj = d & 31, fi = jj & 15;
      F4 cs = {1.f, 1.f, 1.f, 1.f}, sn = {0.f, 0.f, 0.f, 0.f};
      if (pos >= 256) {
        const int t = pos - 256; const int n = jj < 16 ? (t >> 6) : (t & 63);
        cs = ld4f(TABp + n * 16 + fi); sn = ld4f(TABp + 1024 + n * 16 + fi);
      }
      const int cp = c4 ^ 32;
      F4 xq = ld4bf(prr + c4), xqp = ld4bf(prr + cp), xk = ld4bf(prr + 256 + c4), xkp = ld4bf(prr + 256 + cp);
      const float sg = (d < 32) ? -1.f : 1.f;
      asm volatile("" ::: "memory");
      st4bf(prr + c4, xq.a * cs.a + sg * xqp.a * sn.a, xq.b * cs.b + sg * xqp.b * sn.b, xq.c * cs.c + sg * xqp.c * sn.c, xq.d * cs.d + sg * xqp.d * sn.d);
      st4bf(prr + 256 + c4, 0.125f * (xk.a * cs.a + sg * xkp.a * sn.a), 0.125f * (xk.b * cs.b + sg * xkp.b * sn.b),
            0.125f * (xk.c * cs.c + sg * xkp.c * sn.c), 0.125f * (xk.d * cs.d + sg * xkp.d * sn.d));
      F4 lb = ld4f(TABp + 2048 + l * 256 + c4);
      F4 zf = ld4bf(prr + 1536 + c4), zb = ld4bf(prr + 1792 + c4);
      F4 f0 = ld4f(p.in[34] + (l * 2 + 0) * 256 + c4), f1 = ld4f(p.in[34] + (l * 2 + 1) * 256 + c4);
      st4bf(prr + 1536 + c4, (1.f - lb.a) * sigm(-(zf.a + f0.a)), (1.f - lb.b) * sigm(-(zf.b + f0.b)), (1.f - lb.c) * sigm(-(zf.c + f0.c)), (1.f - lb.d) * sigm(-(zf.d + f0.d)));
      st4bf(prr + 1792 + c4, (1.f - lb.a) * sigm(-(zb.a + f1.a)), (1.f - lb.b) * sigm(-(zb.b + f1.b)), (1.f - lb.c) * sigm(-(zb.c + f1.c)), (1.f - lb.d) * sigm(-(zb.d + f1.d)));
    }
  }
}

DEVINL int vrow(int b, int dir, int pp) {
  int pos = dir ? (pp < 256 ? 255 - pp : 2559 - pp) : pp;
  return b * SEQT + pos;
}

typedef float v2f __attribute__((ext_vector_type(2)));
#ifdef NOSB
#define SB()
#else
#define SB() __builtin_amdgcn_sched_barrier(0)
#endif
#define LO2(t) __builtin_shufflevector(t, t, 0, 1)
#define HI2(t) __builtin_shufflevector(t, t, 2, 3)
DEVINL void wave_lds_sync() {
  __builtin_amdgcn_fence(__ATOMIC_RELEASE, "wavefront");
  __builtin_amdgcn_wave_barrier();
  __builtin_amdgcn_fence(__ATOMIC_ACQUIRE, "wavefront");
}

DEVINL float dpp_xor1(float x) { return __int_as_float(__builtin_amdgcn_update_dpp(0, __float_as_int(x), 0xB1, 0xF, 0xF, true)); }
DEVINL float dpp_xor2(float x) { return __int_as_float(__builtin_amdgcn_update_dpp(0, __float_as_int(x), 0x4E, 0xF, 0xF, true)); }

typedef _Float16 h2 __attribute__((ext_vector_type(2)));
typedef _Float16 h8 __attribute__((ext_vector_type(8)));
#define H2(q, j) (h2{(q)[2 * (j)], (q)[2 * (j) + 1]})
DEVINL void scan_rwkv(const Params& p, int l, int b, int dir, int h, int quarter, int lane, float* sw) {
  asm volatile("" : "+v"(lane));
  __builtin_amdgcn_s_setprio(3);
  char* ws = p.ws;
  const bf16_t* RKV = (const bf16_t*)(ws + OFF_AR + AR_RKV);
  const bf16_t* L = (const bf16_t*)(ws + OFF_AR + AR_L);
  bf16_t* O = (bf16_t*)(ws + OFF_AR + AR_OUT) + (size_t)(dir ? 4 : 0) * OUTSLOT;
  const int c = h * 64 + lane;
  const int kp = lane & 3, myrow = quarter * 16 + (lane >> 2);
  const float kac = p.in[19][l * 256 + c];
  h2 S[8];
#pragma unroll
  for (int k = 0; k < 8; ++k) S[k] = h2{(_Float16)0.f, (_Float16)0.f};
  bf16_t rr[8], rk[8], rv[8], rkk[8], rw[8], ra[8];
#define RWKV_LOADRAW(CH)                                                  \
  _Pragma("unroll") for (int s = 0; s < 8; ++s) {                         \
    int row = vrow(b, dir, (CH) * 8 + s);                                 \
    rr[s] = RKV[(size_t)row * 1024 + c];                                  \
    rk[s] = RKV[(size_t)row * 1024 + 256 + c];                            \
    rv[s] = RKV[(size_t)row * 1024 + 512 + c];                            \
    rkk[s] = RKV[(size_t)row * 1024 + 768 + c];                           \
    rw[s] = L[(size_t)row * 1280 + dir * 256 + c];                        \
    ra[s] = L[(size_t)row * 1280 + 512 + dir * 256 + c];                  \
  }
#define RWKV_LD(Q, VV, S_)                                                              \
  { const float* base_ = sw + (S_) * 224;                                               \
    _Pragma("unroll") for (int a = 0; a < 5; ++a) {                                     \
      Q[2 * a] = *(const h8*)(base_ + a * 32 + kp * 8);                                 \
      Q[2 * a + 1] = *(const h8*)(base_ + a * 32 + kp * 8 + 4); }                       \
    VV = base_[160 + myrow]; }
#define RWKV_CMP(Q, VV, S_)                                                             \
  { h2 sa0 = h2{(_Float16)0.f, (_Float16)0.f}, sa1 = sa0;                               \
    _Pragma("unroll") for (int i = 0; i < 4; ++i) { sa0 += S[i] * H2(Q[0], i); sa1 += S[4 + i] * H2(Q[1], i); } \
    float sa = ((float)sa0.x + (float)sa0.y) + ((float)sa1.x + (float)sa1.y);           \
    sa += dpp_xor1(sa); sa += dpp_xor2(sa);                                             \
    const h2 sasa = h2{(_Float16)sa, (_Float16)sa}, vv = h2{(_Float16)(VV), (_Float16)(VV)}; \
    h2 y0 = h2{(_Float16)0.f, (_Float16)0.f}, y1 = y0;                                  \
    _Pragma("unroll") for (int g = 0; g < 2; ++g) _Pragma("unroll") for (int i = 0; i < 4; ++i) { \
      const h2 nw = H2(Q[2 + g], i), bq = H2(Q[4 + g], i), dq = H2(Q[6 + g], i), rq = H2(Q[8 + g], i); \
      const h2 t = vv * dq - sasa * bq;                                                 \
      const h2 u = S[4 * g + i] + t;                                                    \
      S[4 * g + i] = S[4 * g + i] * nw + u;                                             \
      if (g == 0) y0 += S[4 * g + i] * rq; else y1 += S[4 * g + i] * rq;                \
    }                                                                                   \
    float y = ((float)y0.x + (float)y0.y) + ((float)y1.x + (float)y1.y);                \
    y += dpp_xor1(y); y += dpp_xor2(y);                                                 \
    if (kp == 0) { int row = vrow(b, dir, ch * 8 + (S_)); O[(size_t)row * 256 + h * 64 + myrow] = f2bf(y); } }
  RWKV_LOADRAW(0)
#pragma unroll 1
  for (int ch = 0; ch < 288; ++ch) {
#pragma unroll
    for (int s = 0; s < 8; ++s) {
      float r_ = bf2f(rr[s]), k_ = bf2f(rk[s]), v_ = bf2f(rv[s]), kk_ = bf2f(rkk[s]);
      float omw = bf2f(rw[s]), a_ = bf2f(ra[s]);
      float kd_ = k_ * (1.f + (a_ - 1.f) * kac);
      _Float16* q = (_Float16*)(sw + s * 224);
      q[lane] = (_Float16)kk_; q[64 + lane] = (_Float16)(-omw); q[128 + lane] = (_Float16)(kk_ * a_); q[192 + lane] = (_Float16)kd_; q[256 + lane] = (_Float16)r_;
      sw[s * 224 + 160 + lane] = v_;
    }
    wave_lds_sync();
    if (ch + 1 < 288) { RWKV_LOADRAW(ch + 1) }
    SB();
    h8 QA[10], QB[10]; float vA, vB;
    RWKV_LD(QA, vA, 0) SB();
    RWKV_LD(QB, vB, 1) SB(); RWKV_CMP(QA, vA, 0) SB();
    RWKV_LD(QA, vA, 2) SB(); RWKV_CMP(QB, vB, 1) SB();
    RWKV_LD(QB, vB, 3) SB(); RWKV_CMP(QA, vA, 2) SB();
    RWKV_LD(QA, vA, 4) SB(); RWKV_CMP(QB, vB, 3) SB();
    RWKV_LD(QB, vB, 5) SB(); RWKV_CMP(QA, vA, 4) SB();
    RWKV_LD(QA, vA, 6) SB(); RWKV_CMP(QB, vB, 5) SB();
    RWKV_LD(QB, vB, 7) SB(); RWKV_CMP(QA, vA, 6) SB();
    RWKV_CMP(QB, vB, 7) SB();
    wave_lds_sync();
  }
  __builtin_amdgcn_s_setprio(0);
#undef RWKV_LOADRAW
#undef RWKV_LD
#undef RWKV_CMP
}

template <int MODE>
DEVINL void scan_gla(const Params& p, int l, int b, int dir, int h, int quarter, int lane, float* sw) {
  asm volatile("" : "+v"(lane));
  __builtin_amdgcn_s_setprio(3);
  char* ws = p.ws;
  const bf16_t* PR = (const bf16_t*)(ws + OFF_AR + AR_PREST);
  bf16_t* O = (bf16_t*)(ws + OFF_AR + AR_OUT) + (size_t)(MODE == 0 ? (dir ? 6 : 3) : (dir ? 5 : 1)) * OUTSLOT;
  const int c = h * 64 + lane;
  const int dp = lane & 3, mycol = quarter * 16 + (lane >> 2);
  const float gamma = 1.f - exp2f(-5.f - (float)h);
  const h2 g2 = h2{(_Float16)gamma, (_Float16)gamma};
  h2 S[8];
#pragma unroll
  for (int k = 0; k < 8; ++k) S[k] = h2{(_Float16)0.f, (_Float16)0.f};
  bf16_t r0[8], r1[8], r2[8];
  const int cA = (MODE == 0) ? ((dir ? 1792 : 1536) + c) : (256 + c);
  const int cQ = (MODE == 0) ? (1280 + c) : c;
  const int cV = (MODE == 0) ? (2048 + c) : (512 + c);
#define GLA_LOADRAW(CH)                                                              \
  _Pragma("unroll") for (int s = 0; s < 8; ++s) {                                    \
    int row = vrow(b, dir, (CH) * 8 + s);                                            \
    const bf16_t* pr = PR + (size_t)row * PREST;                                     \
    r0[s] = pr[cA]; r1[s] = pr[cQ]; r2[s] = pr[cV];                                  \
  }
#define GLA_LD(Q, VV, S_)                                                            \
  { const float* base_ = sw + (S_) * 128;                                            \
    Q[0] = *(const h8*)(base_ + dp * 8); Q[1] = *(const h8*)(base_ + dp * 8 + 4);    \
    Q[2] = *(const h8*)(base_ + 32 + dp * 8); Q[3] = *(const h8*)(base_ + 32 + dp * 8 + 4); \
    VV = base_[64 + mycol]; }
#define GLA_CMP(Q, VV, S_)                                                           \
  { const h2 vv = h2{(_Float16)(VV), (_Float16)(VV)}; h2 o0 = h2{(_Float16)0.f, (_Float16)0.f}, o1 = o0; \
    _Pragma("unroll") for (int g_ = 0; g_ < 2; ++g_) _Pragma("unroll") for (int i = 0; i < 4; ++i) { \
      const h2 a2 = H2(Q[g_], i), q2 = H2(Q[2 + g_], i);                             \
      if (MODE == 0) {                      \
        S[4 * g_ + i] = S[4 * g_ + i] - a2 * (S[4 * g_ + i] - vv);                   \
        if (g_ == 0) o0 += S[4 * g_ + i] * q2; else o1 += S[4 * g_ + i] * q2;        \
      } else {                                                                       \
        if (dir) { if (g_ == 0) o0 += S[4 * g_ + i] * q2; else o1 += S[4 * g_ + i] * q2; } \
        S[4 * g_ + i] = g2 * S[4 * g_ + i] + a2 * vv;                                \
        if (!dir) { if (g_ == 0) o0 += S[4 * g_ + i] * q2; else o1 += S[4 * g_ + i] * q2; } \
      }                                                                              \
    }                                                                                \
    float o = ((float)o0.x + (float)o0.y) + ((float)o1.x + (float)o1.y);             \
    o += dpp_xor1(o); o += dpp_xor2(o);                                              \
    if (dp == 0) { int row = vrow(b, dir, ch * 8 + (S_)); O[(size_t)row * 256 + h * 64 + mycol] = f2bf(o); } }
  GLA_LOADRAW(0)
#pragma unroll 1
  for (int ch = 0; ch < 288; ++ch) {
#pragma unroll
    for (int s = 0; s < 8; ++s) {
      _Float16* q = (_Float16*)(sw + s * 128);
      q[lane] = (_Float16)bf2f(r0[s]); q[64 + lane] = (_Float16)bf2f(r1[s]);
      sw[s * 128 + 64 + lane] = bf2f(r2[s]);
    }
    wave_lds_sync();
    if (ch + 1 < 288) { GLA_LOADRAW(ch + 1) }
    SB();
    h8 QA[4], QB[4]; float vA, vB;
    GLA_LD(QA, vA, 0) SB();
    GLA_LD(QB, vB, 1) SB(); GLA_CMP(QA, vA, 0) SB();
    GLA_LD(QA, vA, 2) SB(); GLA_CMP(QB, vB, 1) SB();
    GLA_LD(QB, vB, 3) SB(); GLA_CMP(QA, vA, 2) SB();
    GLA_LD(QA, vA, 4) SB(); GLA_CMP(QB, vB, 3) SB();
    GLA_LD(QB, vB, 5) SB(); GLA_CMP(QA, vA, 4) SB();
    GLA_LD(QA, vA, 6) SB(); GLA_CMP(QB, vB, 5) SB();
    GLA_LD(QB, vB, 7) SB(); GLA_CMP(QA, vA, 6) SB();
    GLA_CMP(QB, vB, 7) SB();
    wave_lds_sync();
  }
  __builtin_amdgcn_s_setprio(0);
#undef GLA_LOADRAW
#undef GLA_LD
#undef GLA_CMP
}

DEVINL void scan_s5(const Params& p, int l, int b, int dir, int g, int lane, float* smC) {
  asm volatile("" : "+v"(lane));
  char* ws = p.ws;
  const bf16_t* PR = (const bf16_t*)(ws + OFF_AR + AR_PREST);
  bf16_t* O = (bf16_t*)(ws + OFF_AR + AR_OUT) + (size_t)(dir ? 7 : 8) * OUTSLOT;
  _Float16* hC = (_Float16*)smC;
  _Float16* hS = (_Float16*)(smC + 1024);
  float* smU = smC + 2048;
  const size_t gi = (size_t)((l * 2 + dir) * 16 + g);
  float lbr, lbi; h2 bb[16];
  {
    float lr = p.in[23][gi * 64 + lane], li = p.in[24][gi * 64 + lane];
    float dt = expf(p.in[25][gi]);
    float mag = expf(lr * dt);
    lbr = mag * cosf(li * dt); lbi = mag * sinf(li * dt);
    float den = lr * lr + li * li;
    float fre = ((lbr - 1.f) * lr + lbi * li) / den;
    float fim = (lbi * lr - (lbr - 1.f) * li) / den;
    const float* br = p.in[26] + (gi * 64 + lane) * 16;
    const float* bi = p.in[27] + (gi * 64 + lane) * 16;
#pragma unroll
    for (int i = 0; i < 16; ++i) {
      float r_ = br[i], i_ = bi[i];
      bb[i] = h2{(_Float16)(fre * r_ - fim * i_), (_Float16)(fre * i_ + fim * r_)};
    }
    const float* cr = p.in[28] + gi * 1024;
    const float* ci = p.in[29] + gi * 1024;
#pragma unroll
    for (int o = 0; o < 16; ++o) {
      hC[(o * 2 + 0) * 64 + lane] = (_Float16)cr[o * 64 + lane];
      hC[(o * 2 + 1) * 64 + lane] = (_Float16)ci[o * 64 + lane];
    }
  }
  float sre = 0.f, sim = 0.f;
  const int ts = lane >> 2, i4 = lane & 3;
  uint2 raw = *(const uint2*)(PR + (size_t)vrow(b, dir, ts) * PREST + 1024 + g * 16 + i4 * 4);
#pragma unroll 1
  for (int ch = 0; ch < 144; ++ch) {
    {
      h2 d0, d1, d2, d3;
      _Float16 u0 = (_Float16)bf2f((bf16_t)(raw.x & 0xffff)), u1 = (_Float16)bf2f((bf16_t)(raw.x >> 16));
      _Float16 u2 = (_Float16)bf2f((bf16_t)(raw.y & 0xffff)), u3 = (_Float16)bf2f((bf16_t)(raw.y >> 16));
      d0 = h2{u0, u0}; d1 = h2{u1, u1}; d2 = h2{u2, u2}; d3 = h2{u3, u3};
      h8 pk = h8{d0.x, d0.y, d1.x, d1.y, d2.x, d2.y, d3.x, d3.y};
      *(h8*)(smU + ts * 16 + i4 * 4) = pk;
    }
    wave_lds_sync();
    if (ch + 1 < 144) raw = *(const uint2*)(PR + (size_t)vrow(b, dir, (ch + 1) * 16 + ts) * PREST + 1024 + g * 16 + i4 * 4);
#pragma unroll 4
    for (int s = 0; s < 16; ++s) {
      const h8* u = (const h8*)(smU + s * 16);
      h8 u0 = u[0], u1 = u[1], u2 = u[2], u3 = u[3];
      h2 a0 = bb[0] * H2(u0, 0), a1 = bb[1] * H2(u0, 1);
      a0 += bb[2] * H2(u0, 2); a1 += bb[3] * H2(u0, 3);
      a0 += bb[4] * H2(u1, 0); a1 += bb[5] * H2(u1, 1);
      a0 += bb[6] * H2(u1, 2); a1 += bb[7] * H2(u1, 3);
      a0 += bb[8] * H2(u2, 0); a1 += bb[9] * H2(u2, 1);
      a0 += bb[10] * H2(u2, 2); a1 += bb[11] * H2(u2, 3);
      a0 += bb[12] * H2(u3, 0); a1 += bb[13] * H2(u3, 1);
      a0 += bb[14] * H2(u3, 2); a1 += bb[15] * H2(u3, 3);
      const float bur = (float)a0.x + (float)a1.x, bui = (float)a0.y + (float)a1.y;
      float nre = lbr * sre - lbi * sim + bur;
      float nim = lbr * sim + lbi * sre + bui;
      sre = nre; sim = nim;
      hS[(s * 2 + 0) * 64 + lane] = (_Float16)sre;
      hS[(s * 2 + 1) * 64 + lane] = (_Float16)sim;
    }
    wave_lds_sync();
    {
      h2 acc[4];
#pragma unroll
      for (int oo = 0; oo < 4; ++oo) acc[oo] = h2{(_Float16)0.f, (_Float16)0.f};
      const _Float16* sr = hS + (ts * 2 + 0) * 64;
      const _Float16* si = hS + (ts * 2 + 1) * 64;
#pragma unroll 4
      for (int p8 = 0; p8 < 8; ++p8) {
        h8 a = *(const h8*)(sr + p8 * 8), bq = *(const h8*)(si + p8 * 8);
#pragma unroll
        for (int oo = 0; oo < 4; ++oo) {
          int o = i4 * 4 + oo;
          h8 cr8 = *(const h8*)(hC + (o * 2 + 0) * 64 + p8 * 8);
          h8 ci8 = *(const h8*)(hC + (o * 2 + 1) * 64 + p8 * 8);
#pragma unroll
          for (int j = 0; j < 4; ++j) { acc[oo] += H2(cr8, j) * H2(a, j); acc[oo] -= H2(ci8, j) * H2(bq, j); }
        }
      }
      int row = vrow(b, dir, ch * 16 + ts);
      uint2 pk;
      pk.x = (unsigned)f2bf((float)acc[0].x + (float)acc[0].y) | ((unsigned)f2bf((float)acc[1].x + (float)acc[1].y) << 16);
      pk.y = (unsigned)f2bf((float)acc[2].x + (float)acc[2].y) | ((unsigned)f2bf((float)acc[3].x + (float)acc[3].y) << 16);
      *(uint2*)(O + (size_t)row * 256 + g * 16 + i4 * 4) = pk;
    }
    wave_lds_sync();
  }
}

DEVINL void phase_scans(const Params& p, int l, float* smf) {
  const int tid = otid(p.wave), lane = tid & 63, wid = __builtin_amdgcn_readfirstlane(tid >> 6);
  for (int task = blockIdx.x; task < 256; task += gridDim.x) {
    if (wid < 2) {
      const int chain = task >> 1, quarter = (task & 1) * 2 + wid;
      scan_rwkv(p, l, chain >> 3, (chain >> 2) & 1, chain & 3, quarter, lane, smf + wid * 1792);
    } else if (wid < 4) {
      const int t2 = task + (wid - 2) * 256;
      scan_s5(p, l, t2 >> 5, (t2 >> 4) & 1, t2 & 15, lane, smf + 9728 + (wid - 2) * 4352);
    } else {
      const int chain = task & 127, quarter = wid - 4;
      if (task < 128) scan_gla<0>(p, l, chain >> 3, (chain >> 2) & 1, chain & 3, quarter, lane, smf + 3584 + quarter * 1536);
      else scan_gla<1>(p, l, chain >> 3, (chain >> 2) & 1, chain & 3, quarter, lane, smf + 3584 + quarter * 1536);
    }
  }
}

DEVINL void phase_post(const Params& p, int l, bool skipctx = false) {
  char* ws = p.ws;
  bf16_t* OUTp = (bf16_t*)(ws + OFF_AR + AR_OUT);
  const bf16_t* PR = (const bf16_t*)(ws + OFF_AR + AR_PREST);
  const bf16_t* RKV = (const bf16_t*)(ws + OFF_AR + AR_RKV);
  const bf16_t* L = (const bf16_t*)(ws + OFF_AR + AR_L);
  const int lane = otid(p.wave) & 63, wid = otid(p.wave) >> 6;
  const int gw = blockIdx.x * 8 + wid, nw = gridDim.x * 8;
  const int c = lane * 4;
  const F4 gn_a = ld4f(p.in[21] + l * 256 + c), ka = ld4f(p.in[19] + l * 256 + c), rk = ld4f(p.in[20] + l * 256 + c);
  const F4 gn_b = ld4f(p.in[22] + l * 256 + c), dsk = ld4f(p.in[30] + l * 256 + c), gn_d = ld4f(p.in[35] + l * 256 + c);
  for (int row = gw; row < MROWS; row += nw) {
    if (skipctx && (row % SEQT) < 256) continue;
    const size_t ro = (size_t)row * 256 + c;
    {
      F4 y0 = ld4bf(OUTp + 0 * OUTSLOT + ro), y1 = ld4bf(OUTp + 4 * OUTSLOT + ro);
      float a0 = y0.a + y1.a, a1 = y0.b + y1.b, a2 = y0.c + y1.c, a3 = y0.d + y1.d;
      float mean = row16_sum(a0 + a1 + a2 + a3) * (1.f / 64.f);
      a0 -= mean; a1 -= mean; a2 -= mean; a3 -= mean;
      float rs = rsqrtf(row16_sum(a0 * a0 + a1 * a1 + a2 * a2 + a3 * a3) * (1.f / 64.f) + 64e-5f);
      F4 r_ = ld4bf(RKV + (size_t)row * 1024 + c), k_ = ld4bf(RKV + (size_t)row * 1024 + 256 + c), v_ = ld4bf(RKV + (size_t)row * 1024 + 512 + c);
      F4 af = ld4bf(L + (size_t)row * 1280 + 512 + c), ab = ld4bf(L + (size_t)row * 1280 + 768 + c), gg = ld4bf(L + (size_t)row * 1280 + 1024 + c);
      float t = r_.a * k_.a * rk.a * (2.f + (af.a + ab.a - 2.f) * ka.a) + r_.b * k_.b * rk.b * (2.f + (af.b + ab.b - 2.f) * ka.b)
              + r_.c * k_.c * rk.c * (2.f + (af.c + ab.c - 2.f) * ka.c) + r_.d * k_.d * rk.d * (2.f + (af.d + ab.d - 2.f) * ka.d);
      float bs = row16_sum(t);
      st4bf(OUTp + 0 * OUTSLOT + ro, (a0 * rs * gn_a.a + bs * v_.a) * gg.a, (a1 * rs * gn_a.b + bs * v_.b) * gg.b,
            (a2 * rs * gn_a.c + bs * v_.c) * gg.c, (a3 * rs * gn_a.d + bs * v_.d) * gg.d);
    }
    {
      F4 y0 = ld4bf(OUTp + 1 * OUTSLOT + ro), y1 = ld4bf(OUTp + 5 * OUTSLOT + ro);
      float a0 = y0.a + y1.a, a1 = y0.b + y1.b, a2 = y0.c + y1.c, a3 = y0.d + y1.d;
      float mean = row16_sum(a0 + a1 + a2 + a3) * (1.f / 64.f);
      a0 -= mean; a1 -= mean; a2 -= mean; a3 -= mean;
      float rs = rsqrtf(row16_sum(a0 * a0 + a1 * a1 + a2 * a2 + a3 * a3) * (1.f / 64.f) + 1e-5f);
      F4 g = ld4bf(PR + (size_t)row * PREST + 768 + c);
      st4bf(OUTp + 1 * OUTSLOT + ro, a0 * rs * gn_b.a * silu(g.a), a1 * rs * gn_b.b * silu(g.b), a2 * rs * gn_b.c * silu(g.c), a3 * rs * gn_b.d * silu(g.d));
    }
    {
      F4 u = ld4bf(PR + (size_t)row * PREST + 1024 + c);
      F4 y0 = ld4bf(OUTp + 8 * OUTSLOT + ro), y1 = ld4bf(OUTp + 7 * OUTSLOT + ro);
      float e0 = dsk.a * u.a + y0.a + y1.a, e1 = dsk.b * u.b + y0.b + y1.b, e2 = dsk.c * u.c + y0.c + y1.c, e3 = dsk.d * u.d + y0.d + y1.d;
      e0 = 0.5f * e0 * (1.f + tanh_fast(0.7978845608028654f * (e0 + 0.044715f * e0 * e0 * e0)));
      e1 = 0.5f * e1 * (1.f + tanh_fast(0.7978845608028654f * (e1 + 0.044715f * e1 * e1 * e1)));
      e2 = 0.5f * e2 * (1.f + tanh_fast(0.7978845608028654f * (e2 + 0.044715f * e2 * e2 * e2)));
      e3 = 0.5f * e3 * (1.f + tanh_fast(0.7978845608028654f * (e3 + 0.044715f * e3 * e3 * e3)));
      st4bf(OUTp + 8 * OUTSLOT + ro, e0, e1, e2, e3);
    }
    {
      F4 y0 = ld4bf(OUTp + 3 * OUTSLOT + ro), y1 = ld4bf(OUTp + 6 * OUTSLOT + ro);
      float a0 = y0.a + y1.a, a1 = y0.b + y1.b, a2 = y0.c + y1.c, a3 = y0.d + y1.d;
      float rs = rsqrtf(row16_sum(a0 * a0 + a1 * a1 + a2 * a2 + a3 * a3) * (1.f / 64.f) + 1e-5f);
      F4 g = ld4bf(PR + (size_t)row * PREST + 2304 + c);
      st4bf(OUTp + 3 * OUTSLOT + ro, a0 * rs * gn_d.a * silu(g.a), a1 * rs * gn_d.b * silu(g.b), a2 * rs * gn_d.c * silu(g.c), a3 * rs * gn_d.d * silu(g.d));
    }
  }
}

__global__ void __launch_bounds__(512, 2) mega(Params p_in) {
  Params p = p_in;
  p.wave = __builtin_amdgcn_readfirstlane((int)threadIdx.x >> 6);
  cg::grid_group grid = cg::this_grid();
  extern __shared__ __attribute__((aligned(16))) unsigned char smem[];
  float* smf = (float*)smem;
  char* ws = p.ws;

  if (p.ws_size < WS_NEED) {
    for (size_t i = (size_t)blockIdx.x * 512 + otid(p.wave); i < (size_t)NB * 2048 * 1024; i += (size_t)gridDim.x * 512)
      p.out[i] = __uint_as_float(0x7fc00000u);
    return;
  }

  unsigned* barw = (unsigned*)(ws + OFF_BAR);
  volatile XLAS unsigned* xst = (volatile XLAS unsigned*)(XLAS unsigned char*)(smem + 131072);
  if (blockIdx.x == 0) for (int i = otid(p.wave); i < XCD_BAR_WORDS; i += 512) barw[i] = 0u;
  if (otid(p.wave) < 4) xst[otid(p.wave)] = 0u;
  phase_ada_partial(p, smf);
  phase_tables(p);
  grid.sync();
  (void)xcd_barrier_post(p.wave, barw, xst);
  phase_ada_reduce(p);
  xcd_barrier(p, smem);

  float* X = (float*)(ws + OFF_X);
  const float* Mod = (const float*)(ws + OFF_MOD);
  bf16_t* HFFN = (bf16_t*)(ws + OFF_AR + AR_HFFN);
  bf16_t* HMIX = (bf16_t*)(ws + OFF_AR + AR_HMIX);
  bf16_t* HP = (bf16_t*)(ws + OFF_AR + AR_HP);
  bf16_t* U = (bf16_t*)(ws + OFF_AR + AR_U);
  bf16_t* OUTp = (bf16_t*)(ws + OFF_AR + AR_OUT);
  bf16_t* BR = (bf16_t*)(ws + OFF_AR + AR_BR);

  for (int l = 0; l < DEPTH; ++l) {
    if (l == 0) phase_lnmod(p, true, false, 0, 0, 0, 0, HFFN, false);
    else phase_lnmod(p, false, true, l - 1, 2, l, 0, HFFN, false);
    const int idle0 = (576 % (int)gridDim.x);
    if (l == 0) { conv_ffn(p, 0, 0, smf, 0, 1408); }
    xcd_barrier(p, smem);
    run_gemm(p.wave, smem, HFFN, (const bf16_t*)(ws + OFF_W13), MROWS, 5632, 1024, EpiSwiglu{U});
    conv_ffn(p, l, 0, smf, 1408, 2112, 3168 % (int)gridDim.x);
    xcd_barrier(p, smem);
    run_gemm(p.wave, smem, U, (const bf16_t*)(ws + OFF_W2), MROWS, 1024, FF, EpiResid{X, Mod, l, 2, 0.5f});
    conv_mix(p, l, smf, idle0);
    xcd_barrier(p, smem);
    phase_lnmod(p, false, true, l, 0, l, 3, HMIX, false);
    xcd_barrier(p, smem);
    run_gemm(p.wave, smem, HMIX, (const bf16_t*)(ws + OFF_WIN), MROWS, 3840, 1024,
             EpiPin{(bf16_t*)(ws + OFF_AR + AR_PRW), (bf16_t*)(ws + OFF_AR + AR_PREST)});
    xcd_barrier(p, smem);
    phase_shift(p, l);
    xcd_barrier(p, smem);
    run_gemm(p.wave, smem, (const bf16_t*)(ws + OFF_AR + AR_A2), (const bf16_t*)(ws + OFF_WL), MROWS, 1280, 384,
             EpiLora{(bf16_t*)(ws + OFF_AR + AR_L), p.in[13] + l * 512, p.in[15] + l * 512});
    xcd_barrier(p, smem);
    phase_scans(p, l, smf);
    xcd_barrier(p, smem);
    const int last = (l == DEPTH - 1);
    phase_post(p, l, last);
    xcd_barrier(p, smem);
    run_gemm(p.wave, smem, OUTp + 8 * OUTSLOT, (const bf16_t*)(ws + OFF_WGLU), MROWS, 256, 256,
             EpiGlu{OUTp + 8 * OUTSLOT, OUTp + 2 * OUTSLOT, p.in[32] + l * 256}, last);
    phase_lnmod(p, false, false, 0, 0, l, 3, HP, false, last);
    xcd_barrier(p, smem);
    run_gemm<EpiBranch, pg8::BranchOrder>(p.wave, smem, OUTp, (const bf16_t*)(ws + OFF_WB), 4 * MROWS, 1024, 256, EpiBranch{BR}, last);
    xcd_barrier(p, smem);
    run_gemm(p.wave, smem, HP, (const bf16_t*)(ws + OFF_WG), MROWS, 4096, 1024, EpiGate{BR, p.in[38] + (size_t)l * 4096}, last);
    xcd_barrier(p, smem);
    run_gemm(p.wave, smem, BR, (const bf16_t*)(ws + OFF_WO4), MROWS, 1024, 4096, EpiResid{X, Mod, l, 5, 1.0f}, last);
    conv_ffn(p, l, 1, smf, 0, 2112, last ? 0 : idle0);
    xcd_barrier(p, smem);
    phase_lnmod(p, false, true, l, 1, l, 6, HFFN, false, last);
    xcd_barrier(p, smem);
    run_gemm(p.wave, smem, HFFN, (const bf16_t*)(ws + OFF_W13), MROWS, 5632, 1024, EpiSwiglu{U}, last);
    xcd_barrier(p, smem);
    run_gemm(p.wave, smem, U, (const bf16_t*)(ws + OFF_W2), MROWS, 1024, FF, EpiResid{X, Mod, l, 8, 0.5f}, last);
    if (l + 1 < DEPTH) conv_ffn(p, l + 1, 0, smf, 0, 1408, idle0);
    xcd_barrier(p, smem);
  }
  phase_lnmod(p, false, true, DEPTH - 1, 2, 0, 0, HFFN, true, true);
}

extern "C" void kernel_launch(void* const* d_in, const int* in_sizes, int n_in, void* d_out, int out_size,
                              void* d_ws, size_t ws_size, hipStream_t stream) {
  static int grid_blocks = 0;
  if (!grid_blocks) {
    int dev = 0, cus = 0, per_cu = 0;
    (void)hipGetDevice(&dev);
    (void)hipDeviceGetAttribute(&cus, hipDeviceAttributeMultiprocessorCount, dev);
    (void)hipFuncSetAttribute((const void*)mega, hipFuncAttributeMaxDynamicSharedMemorySize, LDS_BYTES);
    (void)hipOccupancyMaxActiveBlocksPerMultiprocessor(&per_cu, mega, 512, LDS_BYTES);
    if (per_cu > 1) per_cu = 1;
    if (per_cu < 1) per_cu = 1;
    grid_blocks = cus * per_cu;
  }
  Params p{};
  for (int i = 0; i < 40; ++i) p.in[i] = (const float*)d_in[i];
  p.out = (float*)d_out;
  p.ws = (char*)d_ws;
  p.ws_size = (unsigned long long)ws_size;
  void* args[] = {&p};
  hipError_t e = hipLaunchCooperativeKernel((void*)mega, dim3(grid_blocks), dim3(512), args, LDS_BYTES, stream);
  if (e != hipSuccess) fprintf(stderr, "cooperative launch failed: %s (grid %d)\n", hipGetErrorString(e), grid_blocks);
}
```

```cpp
#include <hip/hip_runtime.h>
#include <hip/hip_cooperative_groups.h>
#include <cstdio>
#include <cstdint>
namespace cg = cooperative_groups;

typedef unsigned short bf16_t;
using bf16x8 = __attribute__((ext_vector_type(8))) short;
using f32x4 = __attribute__((ext_vector_type(4))) float;

#define DEVINL __device__ __forceinline__

constexpr int NB = 16, SEQT = 2304, MROWS = NB * SEQT;
constexpr int D = 1024, FF = 2816, DEPTH = 4;
constexpr int PRW = 1056, PREST = 2560;
constexpr float ALPHA = 1.681792830507429f;
constexpr int LDS_BYTES = 131072 + 256;

constexpr size_t OFF_X = 0;
constexpr size_t OFF_MOD = OFF_X + (size_t)MROWS * 1024 * 4;
constexpr size_t OFF_TAB = OFF_MOD + (size_t)4 * 17 * 9216 * 4;
constexpr size_t OFF_W13 = OFF_TAB + 12288;
constexpr size_t OFF_W2 = OFF_W13 + (size_t)5632 * 1024 * 2;
constexpr size_t OFF_WIN = OFF_W2 + (size_t)1024 * 2816 * 2;
constexpr size_t OFF_WG = OFF_WIN + (size_t)3840 * 1024 * 2;
constexpr size_t OFF_WB = OFF_WG + (size_t)4096 * 1024 * 2;
constexpr size_t OFF_WO4 = OFF_WB + (size_t)4096 * 256 * 2;
constexpr size_t OFF_WL = OFF_WO4 + (size_t)1024 * 4096 * 2;
constexpr size_t OFF_WGLU = OFF_WL + (size_t)1280 * 384 * 2;
constexpr size_t OFF_BAR = OFF_WGLU + (size_t)256 * 256 * 2;
constexpr size_t OFF_AR = OFF_BAR + 16384;
constexpr size_t AR_PREST = 0;
constexpr size_t AR_L = AR_PREST + (size_t)MROWS * PREST * 2;
constexpr size_t AR_RKV = AR_L + (size_t)MROWS * 1280 * 2;
constexpr size_t AR_OUT = AR_RKV + (size_t)MROWS * 1024 * 2;
constexpr size_t AR_END = AR_OUT + (size_t)9 * MROWS * 256 * 2;
constexpr size_t AR_PRW = AR_OUT;
constexpr size_t AR_A2 = AR_OUT + (size_t)MROWS * PRW * 2;
constexpr size_t AR_HFFN = 0;
constexpr size_t AR_U = (size_t)MROWS * 1024 * 2;
constexpr size_t AR_HMIX = AR_L;
constexpr size_t AR_BR = 0;
constexpr size_t AR_MODP = 0;
constexpr size_t WS_NEED = OFF_AR + AR_END;
constexpr size_t OUTSLOT = (size_t)MROWS * 256;
constexpr size_t AR_HP = AR_OUT + 4 * OUTSLOT * 2;
static_assert((size_t)MROWS * 4096 * 2 <= AR_OUT, "Br must not reach the OUT slots");

struct Params {
  const float* in[40];
  float* out;
  char* ws;
  unsigned long long ws_size;
  int wave;
  int pad_;
};

DEVINL int otid(int wave) { int ln; asm volatile("v_mbcnt_lo_u32_b32 %0, -1, 0\n\tv_mbcnt_hi_u32_b32 %0, -1, %0" : "=v"(ln)); return wave * 64 + ln; }
DEVINL bf16_t f2bf(float f) {
  unsigned u = __float_as_uint(f);
  u += 0x7fffu + ((u >> 16) & 1u);
  return (bf16_t)(u >> 16);
}
DEVINL float bf2f(bf16_t h) { return __uint_as_float(((unsigned)h) << 16); }
typedef __bf16 bf16x2_t __attribute__((ext_vector_type(2)));
DEVINL unsigned pk2(float a, float b) { bf16x2_t v = {(__bf16)a, (__bf16)b}; return __builtin_bit_cast(unsigned, v); }
DEVINL float sigm(float x) { return __builtin_amdgcn_rcpf(1.f + __expf(-x)); }
DEVINL float silu(float x) { return x * __builtin_amdgcn_rcpf(1.f + __expf(-x)); }
DEVINL float tanh_fast(float x) { return 1.f - 2.f * __builtin_amdgcn_rcpf(1.f + __expf(2.f * x)); }
DEVINL float wave_sum(float v) {
#pragma unroll
  for (int o = 32; o > 0; o >>= 1) v += __shfl_xor(v, o);
  return v;
}

DEVINL void conv_tile(int wave, bool valid, const float* __restrict__ src, int ldsrc, int k0, int kval, int n0, int nval,
                      bf16_t* dst, int ldd, int dk0, int mode, int which, int drow0, float* sm) {
  const int tid = otid(wave) & 255;
#pragma unroll
  for (int i = 0; i < 16; ++i) {
    int k = i * 4 + (tid >> 6), n = tid & 63;
    float v = 0.f;
    if (valid && src != nullptr && (k0 + k) < kval && (n0 + n) < nval) v = src[(size_t)(k0 + k) * ldsrc + n0 + n];
    sm[k * 65 + n] = v;
  }
  __syncthreads();
  if (valid) {
#pragma unroll
    for (int i = 0; i < 8; ++i) {
      int j = i * 8 + (tid >> 5), kp = tid & 31;
      int n = n0 + j;
      int drow = (mode == 1) ? ((n >> 4) * 32 + which * 16 + (n & 15)) : (drow0 + j);
      unsigned lo = f2bf(sm[(2 * kp) * 65 + j]), hi = f2bf(sm[(2 * kp + 1) * 65 + j]);
      *(unsigned*)(dst + (size_t)drow * ldd + dk0 + 2 * kp) = lo | (hi << 16);
    }
  }
  __syncthreads();
}

DEVINL void conv_ffn(const Params& p, int l, int i, float* smf, int t_lo = 0, int t_hi = 2112, int blk0 = 0) {
  char* ws = p.ws;
  bf16_t* W13 = (bf16_t*)(ws + OFF_W13);
  bf16_t* W2 = (bf16_t*)(ws + OFF_W2);
  const float* w1 = p.in[8] + (size_t)(l * 2 + i) * 1024 * 2816;
  const float* w3 = p.in[9] + (size_t)(l * 2 + i) * 1024 * 2816;
  const float* w2 = p.in[10] + (size_t)(l * 2 + i) * 2816 * 1024;
  const int half = otid(p.wave) >> 8;
  float* sm = smf + half * 4160;
  if ((int)blockIdx.x < blk0) return;
  for (int t0 = t_lo + ((int)blockIdx.x - blk0) * 2; t0 < t_hi; t0 += ((int)gridDim.x - blk0) * 2) {
    int t = t0 + half; bool valid = t < t_hi; if (!valid) t = t_hi - 1;
    if (t < 1408) {
      int which = t >= 704; int tt = t - which * 704;
      int nt_ = tt % 44, kt = tt / 44;
      conv_tile(p.wave, valid, which ? w3 : w1, 2816, kt * 64, 1024, nt_ * 64, 2816, W13, 1024, kt * 64, 1, which, 0, sm);
    } else {
      int tt = t - 1408; int nt_ = tt % 16, kt = tt / 16;
      conv_tile(p.wave, valid, w2, 1024, kt * 64, 2816, nt_ * 64, 1024, W2, 2816, kt * 64, 0, 0, nt_ * 64, sm);
    }
  }
}

DEVINL void conv_mix(const Params& p, int l, float* smf, int blk0 = 0) {
  char* ws = p.ws;
  const int half = otid(p.wave) >> 8;
  float* sm = smf + half * 4160;
  const int T = 3400;
  if ((int)blockIdx.x < blk0) return;
  for (int t0 = ((int)blockIdx.x - blk0) * 2; t0 < T; t0 += ((int)gridDim.x - blk0) * 2) {
    int t = t0 + half; bool valid = t < T; if (!valid) t = T - 1;
    if (t < 960) {
      int nt_ = t % 60, kt = t / 60;
      conv_tile(p.wave, valid, p.in[11] + (size_t)l * 1024 * 3616, 3616, kt * 64, 1024, nt_ * 64, 3616,
                (bf16_t*)(ws + OFF_WIN), 1024, kt * 64, 0, 0, nt_ * 64, sm);
    } else if (t < 1984) {
      int tt = t - 960; int nt_ = tt % 64, kt = tt / 64;
      conv_tile(p.wave, valid, p.in[37] + (size_t)l * 1024 * 4096, 4096, kt * 64, 1024, nt_ * 64, 4096,
                (bf16_t*)(ws + OFF_WG), 1024, kt * 64, 0, 0, nt_ * 64, sm);
    } else if (t < 2240) {
      int tt = t - 1984; int n = tt >> 6; int r = tt & 63; int nt_ = r % 16, kt = r / 16;
      conv_tile(p.wave, valid, p.in[36] + (size_t)(l * 4 + n) * 256 * 1024, 1024, kt * 64, 256, nt_ * 64, 1024,
                (bf16_t*)(ws + OFF_WB) + (size_t)n * 1024 * 256, 256, kt * 64, 0, 0, nt_ * 64, sm);
    } else if (t < 3264) {
      int tt = t - 2240; int rep = tt >> 8; int r = tt & 255; int nt_ = r % 16, kt = r / 16;
      conv_tile(p.wave, valid, p.in[39] + (size_t)l * 1024 * 1024, 1024, kt * 64, 1024, nt_ * 64, 1024,
                (bf16_t*)(ws + OFF_WO4), 4096, rep * 1024 + kt * 64, 0, 0, nt_ * 64, sm);
    } else if (t < 3280) {
      int tt = t - 3264; int nt_ = tt % 4, kt = tt / 4;
      conv_tile(p.wave, valid, p.in[31] + (size_t)l * 256 * 256, 256, kt * 64, 256, nt_ * 64, 256,
                (bf16_t*)(ws + OFF_WGLU), 256, kt * 64, 0, 0, nt_ * 64, sm);
    } else {
      int tt = t - 3280; int nt_ = tt % 20, kt = tt / 20;
      int seg = nt_ >> 2, sub = nt_ & 3;
      const float* s_ = nullptr; int k0 = 0, kval = 0;
      if (seg == 0 && kt == 0) { s_ = p.in[14] + (size_t)(l * 2 + 0) * 64 * 256; kval = 64; }
      else if (seg == 1 && kt == 0) { s_ = p.in[14] + (size_t)(l * 2 + 1) * 64 * 256; kval = 64; }
      else if (seg == 2 && kt == 1) { s_ = p.in[16] + (size_t)(l * 2 + 0) * 64 * 256; kval = 64; }
      else if (seg == 3 && kt == 1) { s_ = p.in[16] + (size_t)(l * 2 + 1) * 64 * 256; kval = 64; }
      else if (seg == 4 && kt >= 2 && kt <= 4) { s_ = p.in[17] + (size_t)l * 160 * 256; k0 = (kt - 2) * 64; kval = 160; }
      conv_tile(p.wave, valid, s_, 256, k0, kval, sub * 64, 256, (bf16_t*)(ws + OFF_WL), 384, kt * 64, 0, 0, nt_ * 64, sm);
    }
  }
}

namespace pg8 {
#define PG8_LAS __attribute__((address_space(3)))
constexpr int BM = 256, BK = 64, HALF = 128, HTB = HALF * BK * 2, STAGE_BYTES = 8 * HTB, NXCD = 8, WGM = 4;
DEVINL int lds_byte(int r, int c) { const int st = (r >> 4) * 2 + (c >> 5), rr = r & 15, cc = c & 31, ob = rr * 64 + cc * 2; return st * 1024 + (ob ^ (((ob >> 9) & 1) << 5)); }
DEVINL void stage_rc(int b, int& R, int& C) { const int st = b / 1024, sb = b % 1024, swz = sb ^ (((sb >> 9) & 1) << 5); R = (st >> 1) * 16 + swz / 64; C = (st & 1) * 32 + (swz % 64) / 2; }
struct Unit { int pm, pn; };
struct Gemm { const bf16_t* A; const bf16_t* Bt; int M, N, K; };
struct StaticOrder {
    int nM, nN, nwg, G, c, skip;
    DEVINL void init(int M, int N, int G_, int c_, int skip_) { nM = M / BM; if (skip_) nM = (nM / 9) * 8; nN = N / BM; nwg = nM * nN; G = G_; c = c_; skip = skip_; }
    DEVINL bool next(int i, Unit& u) const {
        const long Lx = (long)i * G + c; if (Lx >= nwg) return false;
        int wgid = (int)Lx; { const int q = nwg / NXCD, r = nwg % NXCD, xcd = wgid % NXCD, off = wgid / NXCD; wgid = (xcd < r ? xcd * (q + 1) : r * (q + 1) + (xcd - r) * q) + off; }
        const int nig = WGM * nN, gid = wgid / nig, fm = gid * WGM, gsz = (nM - fm) < WGM ? (nM - fm) : WGM;
        u.pm = fm + ((wgid % nig) % gsz); u.pn = (wgid % nig) / gsz;
        if (skip) u.pm = (u.pm >> 3) * 9 + 1 + (u.pm & 7);
        return true;
    }
    DEVINL void a_ready(const Unit&) const {}
    DEVINL void done(const Unit&) const {}
};
struct BranchOrder : StaticOrder {
    DEVINL bool next(int i, Unit& u) const { if (!StaticOrder::next(i, u)) return false; u.pn = (u.pm / 144) * 4 + u.pn; return true; }
};

template <class Epi, class Sched>
DEVINL void gemm_phase(int wave, PG8_LAS unsigned char* lds, const Gemm g, const Sched& S, const Epi& E) {
    const int tid = otid(wave), wid = __builtin_amdgcn_readfirstlane(tid >> 6), lane = tid & 63, wr = wid >> 2, wc = wid & 3, fr = lane & 15, fq = lane >> 4;
    const int K = g.K, nt = K / BK;
    unsigned voffA[2], voffB[2];
#pragma unroll
    for (int i = 0; i < 2; ++i) { int R, C; stage_rc(tid * 16 + i * 8192, R, C);
        voffA[i] = (unsigned)(R * K + C) * 2u; voffB[i] = (unsigned)(R * K + C) * 2u; }
    const size_t kstep = (size_t)(BK * 2);
    const size_t hstep = (size_t)HALF * K * 2;
    const size_t tstep = 2 * hstep;
    const unsigned ldsw = (unsigned)wid * 1024u;
    const int aoff = lds_byte(wr * 64 + fr, fq * 8), boff = lds_byte(wc * 32 + fr, fq * 8);
#define PG8_SA(b, h) (((b) * 2 + (h)) * HTB)
#define PG8_SB(b, h) ((4 + (b) * 2 + (h)) * HTB)
#define PG8_STAGE(bufoff, gbase, voff) do { _Pragma("unroll") for (int _i = 0; _i < 2; ++_i) \
        __builtin_amdgcn_global_load_lds((const unsigned*)((const char*)(gbase) + (voff)[_i]), (PG8_LAS unsigned*)(lds + (bufoff) + ldsw + _i * 8192), 16, 0, 0); } while (0)
#define PG8_LDA(dst, b, h) do { _Pragma("unroll") for (int m = 0; m < 4; ++m) _Pragma("unroll") for (int k = 0; k < 2; ++k) dst[m][k] = *(const PG8_LAS bf16x8*)(lds + PG8_SA(b, h) + aoff + m * 2048 + k * 1024); } while (0)
#define PG8_LDB(dst, b, h) do { _Pragma("unroll") for (int n = 0; n < 2; ++n) _Pragma("unroll") for (int k = 0; k < 2; ++k) dst[n][k] = *(const PG8_LAS bf16x8*)(lds + PG8_SB(b, h) + boff + n * 2048 + k * 1024); } while (0)
#define PG8_MMA(ai, bj, At, Bt) do { __builtin_amdgcn_s_setprio(1); _Pragma("unroll") for (int m = 0; m < 4; ++m) _Pragma("unroll") for (int n = 0; n < 2; ++n) _Pragma("unroll") for (int k = 0; k < 2; ++k) \
        acc[ai][bj][m][n] = __builtin_amdgcn_mfma_f32_16x16x32_bf16(Bt[n][k], At[m][k], acc[ai][bj][m][n], 0, 0, 0); __builtin_amdgcn_s_setprio(0); } while (0)
#define PG8_WAIT_V(n) asm volatile("s_waitcnt vmcnt(" #n ")" ::: "memory")
#define PG8_WAIT_L(n) asm volatile("s_waitcnt lgkmcnt(" #n ")" ::: "memory")
#define PG8_BAR __builtin_amdgcn_s_barrier()
#define PG8_SCHED __builtin_amdgcn_sched_barrier(0)
    Unit cur, nxt; int ui = 0;
    if (!S.next(0, cur)) return;
    f32x4 acc[2][2][4][2];
#pragma unroll
    for (int a = 0; a < 2; ++a)
#pragma unroll
        for (int b = 0; b < 2; ++b)
#pragma unroll
            for (int m = 0; m < 4; ++m)
#pragma unroll
                for (int n = 0; n < 2; ++n) acc[a][b][m][n] = (f32x4){0.f, 0.f, 0.f, 0.f};
    bf16x8 At[4][2], B0[2][2], B1[2][2];
    const char* cA = (const char*)g.A + (size_t)cur.pm * tstep; const char* cB = (const char*)g.Bt + (size_t)cur.pn * tstep;
    S.a_ready(cur);
    PG8_STAGE(PG8_SB(0, 0), cB, voffB); PG8_STAGE(PG8_SA(0, 0), cA, voffA); PG8_STAGE(PG8_SB(0, 1), cB + hstep, voffB); PG8_STAGE(PG8_SA(0, 1), cA + hstep, voffA);
    if (wr == 1) PG8_BAR;
    PG8_WAIT_V(4); PG8_BAR;
    PG8_STAGE(PG8_SB(1, 0), cB + kstep, voffB); PG8_STAGE(PG8_SA(1, 0), cA + kstep, voffA); PG8_STAGE(PG8_SB(1, 1), cB + hstep + kstep, voffB);
    PG8_WAIT_V(6); PG8_BAR;
    for (;;) {
        const bool has_next = S.next(ui + 1, nxt);
        const char* nA = has_next ? (const char*)g.A + (size_t)nxt.pm * tstep : cA; const char* nB = has_next ? (const char*)g.Bt + (size_t)nxt.pn * tstep : cB;
        for (int t = 0; t < nt; t += 2) {
            const bool last = (t == nt - 2);
            const char* a1 = cA + (size_t)(t + 1) * kstep;
            const char* a2 = last ? nA : cA + (size_t)(t + 2) * kstep; const char* b2 = last ? nB : cB + (size_t)(t + 2) * kstep;
            const char* a3 = a2 + kstep; const char* b3 = b2 + kstep;
            if (last && has_next) S.a_ready(nxt);
            PG8_LDB(B0, 0, 0); PG8_SCHED; PG8_LDA(At, 0, 0); PG8_STAGE(PG8_SA(1, 1), a1 + hstep, voffA);
            PG8_WAIT_L(8); PG8_BAR; PG8_WAIT_L(0); PG8_MMA(0, 0, At, B0); PG8_BAR; PG8_SCHED;
            PG8_LDB(B1, 0, 1); PG8_STAGE(PG8_SB(0, 0), b2, voffB);
            PG8_BAR; PG8_WAIT_L(0); PG8_MMA(0, 1, At, B1); PG8_BAR;
            PG8_LDA(At, 0, 1); PG8_STAGE(PG8_SA(0, 0), a2, voffA);
            PG8_BAR; PG8_WAIT_L(0); PG8_MMA(1, 0, At, B0); PG8_BAR; PG8_SCHED;
            PG8_STAGE(PG8_SB(0, 1), b2 + hstep, voffB);
            PG8_WAIT_V(6); PG8_BAR; PG8_MMA(1, 1, At, B1); PG8_BAR;
            PG8_LDB(B0, 1, 0); PG8_SCHED; PG8_LDA(At, 1, 0); PG8_STAGE(PG8_SA(0, 1), a2 + hstep, voffA);
            PG8_WAIT_L(8); PG8_BAR; PG8_WAIT_L(0); PG8_MMA(0, 0, At, B0); PG8_BAR; PG8_SCHED;
            PG8_LDB(B1, 1, 1); PG8_STAGE(PG8_SB(1, 0), b3, voffB);
            PG8_BAR; PG8_WAIT_L(0); PG8_MMA(0, 1, At, B1); PG8_BAR;
            PG8_LDA(At, 1, 1); PG8_STAGE(PG8_SA(1, 0), a3, voffA);
            PG8_BAR; PG8_WAIT_L(0); PG8_MMA(1, 0, At, B0); PG8_BAR; PG8_SCHED;
            PG8_STAGE(PG8_SB(1, 1), b3 + hstep, voffB);
            PG8_WAIT_V(6); PG8_BAR; PG8_MMA(1, 1, At, B1); PG8_BAR;
        }
        E(acc, cur, wr, wc, fr, fq); S.done(cur);
        if (!has_next) break;
#pragma unroll
        for (int a = 0; a < 2; ++a)
#pragma unroll
            for (int b = 0; b < 2; ++b)
#pragma unroll
                for (int m = 0; m < 4; ++m)
#pragma unroll
                    for (int n = 0; n < 2; ++n) acc[a][b][m][n] = (f32x4){0.f, 0.f, 0.f, 0.f};
        cur = nxt; cA = nA; cB = nB; ++ui;
    }
    PG8_WAIT_V(0);
    if (wr == 0) PG8_BAR;
    PG8_BAR;
#undef PG8_SA
#undef PG8_SB
#undef PG8_STAGE
#undef PG8_LDA
#undef PG8_LDB
#undef PG8_MMA
#undef PG8_WAIT_V
#undef PG8_WAIT_L
#undef PG8_BAR
#undef PG8_SCHED
}
}

using AccT = f32x4[2][2][4][2];
#define EPI_ROWS_BEGIN                                                                     \
  _Pragma("unroll") for (int ai = 0; ai < 2; ++ai) _Pragma("unroll") for (int m = 0; m < 4; ++m) { \
    const int row = rowbase + ai * 128 + m * 16;
#define EPI_ROWS_END }

#define EPI_RLOOP _Pragma("unroll") for (int ai = 0; ai < 2; ++ai) _Pragma("unroll") for (int m = 0; m < 4; ++m)
#define EPI_CLOOP _Pragma("unroll") for (int bj = 0; bj < 2; ++bj) _Pragma("unroll") for (int n = 0; n < 2; ++n)
struct EpiSwiglu {
  static constexpr bool PERM = false, AFTER_DRAIN = false;
  bf16_t* U;
  DEVINL void operator()(const AccT& acc, const pg8::Unit& u, int wr, int wc, int fr, int fq) const {
    const int rowbase = u.pm * 256 + wr * 64 + fr;
#pragma unroll
    for (int bj = 0; bj < 2; ++bj) {
      const int ucol = ((u.pn * 256 + bj * 128 + wc * 32) >> 5) * 16 + 4 * fq;
      EPI_RLOOP {
        const int row = rowbase + ai * 128 + m * 16;
        f32x4 a = acc[ai][bj][m][0], b = acc[ai][bj][m][1];
        uint2 pk; pk.x = pk2(silu(a[0]) * b[0], silu(a[1]) * b[1]); pk.y = pk2(silu(a[2]) * b[2], silu(a[3]) * b[3]);
        *(uint2*)(U + (size_t)row * FF + ucol) = pk;
      }
    }
  }
};
struct EpiResid {
  static constexpr bool PERM = false, AFTER_DRAIN = false;
  float* X; const float* Mod; int ml, mj; float gs;
  DEVINL void operator()(const AccT& acc, const pg8::Unit& u, int wr, int wc, int fr, int fq) const {
    const int rowbase = u.pm * 256 + wr * 64 + fr;
    const int bq = u.pm / 9, mr = (u.pm - bq * 9 == 0) ? 16 : bq;
    const float* gv = Mod + (size_t)(ml * 17 + mr) * 9216 + mj * 1024;
    EPI_CLOOP {
      const int col = u.pn * 256 + bj * 128 + wc * 32 + n * 16 + 4 * fq;
      const f32x4 g4 = *(const f32x4*)(gv + col) * gs;
      EPI_RLOOP {
        const int row = rowbase + ai * 128 + m * 16;
        float* xp = X + (size_t)row * 1024 + col;
        f32x4 x = *(const f32x4*)xp;
        *(f32x4*)xp = x * ALPHA + g4 * acc[ai][bj][m][n];
        if (m & 1) __builtin_amdgcn_sched_barrier(0);
      }
    }
  }
};
struct EpiPin {
  static constexpr bool PERM = false, AFTER_DRAIN = false;
  bf16_t* PRWp; bf16_t* PRp;
  DEVINL void operator()(const AccT& acc, const pg8::Unit& u, int wr, int wc, int fr, int fq) const {
    const int rowbase = u.pm * 256 + wr * 64 + fr;
    EPI_CLOOP {
      const int col = u.pn * 256 + bj * 128 + wc * 32 + n * 16 + 4 * fq;
      EPI_RLOOP {
        const int row = rowbase + ai * 128 + m * 16;
        f32x4 v = acc[ai][bj][m][n];
        uint2 pk; pk.x = pk2(v[0], v[1]); pk.y = pk2(v[2], v[3]);
        if (col < PRW) *(uint2*)(PRWp + (size_t)row * PRW + col) = pk;
        else if (col < 3616) *(uint2*)(PRp + (size_t)row * PREST + (col - PRW)) = pk;
      }
    }
  }
};
struct EpiLora {
  static constexpr bool PERM = false, AFTER_DRAIN = false;
  bf16_t* Lo; const float* w0; const float* a0;
  DEVINL void operator()(const AccT& acc, const pg8::Unit& u, int wr, int wc, int fr, int fq) const {
    const int rowbase = u.pm * 256 + wr * 64 + fr;
    EPI_CLOOP {
      const int col = u.pn * 256 + bj * 128 + wc * 32 + n * 16 + 4 * fq;
      f32x4 b4 = (f32x4){0.f, 0.f, 0.f, 0.f};
      if (u.pn < 2) b4 = *(const f32x4*)(w0 + col);
      else if (u.pn < 4) b4 = *(const f32x4*)(a0 + (col - 512));
      EPI_RLOOP {
        const int row = rowbase + ai * 128 + m * 16;
        f32x4 v = acc[ai][bj][m][n] + b4;
        if (u.pn < 2) {
#pragma unroll
          for (int i = 0; i < 4; ++i) v[i] = 1.f - __expf(-0.6065306597126334f * sigm(v[i]));
        } else if (u.pn < 4) {
#pragma unroll
          for (int i = 0; i < 4; ++i) v[i] = sigm(v[i]);
        }
        uint2 pk; pk.x = pk2(v[0], v[1]); pk.y = pk2(v[2], v[3]);
        *(uint2*)(Lo + (size_t)row * 1280 + col) = pk;
      }
    }
  }
};
struct EpiGlu {
  static constexpr bool PERM = false, AFTER_DRAIN = false;
  const bf16_t* Yin; bf16_t* Yc; const float* bg;
  DEVINL void operator()(const AccT& acc, const pg8::Unit& u, int wr, int wc, int fr, int fq) const {
    const int rowbase = u.pm * 256 + wr * 64 + fr;
    EPI_CLOOP {
      const int col = bj * 128 + wc * 32 + n * 16 + 4 * fq;
      const f32x4 b4 = *(const f32x4*)(bg + col);
      EPI_RLOOP {
        const int row = rowbase + ai * 128 + m * 16;
        uint2 yr = *(const uint2*)(Yin + (size_t)row * 256 + col);
        f32x4 v = acc[ai][bj][m][n] + b4;
        float y0 = bf2f((bf16_t)(yr.x & 0xffff)), y1 = bf2f((bf16_t)(yr.x >> 16)), y2 = bf2f((bf16_t)(yr.y & 0xffff)), y3 = bf2f((bf16_t)(yr.y >> 16));
        uint2 pk; pk.x = pk2(y0 * sigm(v[0]), y1 * sigm(v[1])); pk.y = pk2(y2 * sigm(v[2]), y3 * sigm(v[3]));
        *(uint2*)(Yc + (size_t)row * 256 + col) = pk;
      }
    }
  }
};
struct EpiBranch {
  static constexpr bool PERM = false, AFTER_DRAIN = false;
  bf16_t* Br;
  DEVINL void operator()(const AccT& acc, const pg8::Unit& u, int wr, int wc, int fr, int fq) const {
    const int nb = u.pm / 144, pmr = u.pm - nb * 144;
    const int rowbase = pmr * 256 + wr * 64 + fr;
    EPI_CLOOP {
      const int col = u.pn * 256 + bj * 128 + wc * 32 + n * 16 + 4 * fq;
      EPI_RLOOP {
        const int row = rowbase + ai * 128 + m * 16;
        f32x4 v = acc[ai][bj][m][n];
        uint2 pk; pk.x = pk2(v[0], v[1]); pk.y = pk2(v[2], v[3]);
        *(uint2*)(Br + (size_t)row * 4096 + col) = pk;
      }
    }
  }
};
struct EpiGate {
  static constexpr bool PERM = false, AFTER_DRAIN = false;
  bf16_t* Br; const float* bgate;
  DEVINL void operator()(const AccT& acc, const pg8::Unit& u, int wr, int wc, int fr, int fq) const {
    const int rowbase = u.pm * 256 + wr * 64 + fr;
    EPI_CLOOP {
      const int col = u.pn * 256 + bj * 128 + wc * 32 + n * 16 + 4 * fq;
      const f32x4 b4 = *(const f32x4*)(bgate + col);
      EPI_RLOOP {
        const int row = rowbase + ai * 128 + m * 16;
        bf16_t* bp = Br + (size_t)row * 4096 + col;
        uint2 br = *(const uint2*)bp;
        f32x4 v = acc[ai][bj][m][n] + b4;
        float y0 = bf2f((bf16_t)(br.x & 0xffff)), y1 = bf2f((bf16_t)(br.x >> 16)), y2 = bf2f((bf16_t)(br.y & 0xffff)), y3 = bf2f((bf16_t)(br.y >> 16));
        uint2 pk; pk.x = pk2(y0 * sigm(v[0]), y1 * sigm(v[1])); pk.y = pk2(y2 * sigm(v[2]), y3 * sigm(v[3]));
        *(uint2*)bp = pk;
      }
    }
  }
};

template <class Epi, class Order = pg8::StaticOrder>
DEVINL void run_gemm(int wave, unsigned char* smem, const bf16_t* A, const bf16_t* Bt, int Mo, int N, int K, const Epi& E, int skip = 0) {
  asm volatile("" : "+s"(K), "+s"(N), "+s"(Mo));
  Order S; S.init(Mo, N, gridDim.x, blockIdx.x, skip);
  pg8::gemm_phase<Epi, Order>(wave, (PG8_LAS unsigned char*)smem, pg8::Gemm{A, Bt, Mo, N, K}, S, E);
}

#define XB_TMO      128
#define XB_XCNT(j)  (256  + 64 * (j))
#define XB_XSUB(j)  (1280 + 64 * (j))
#define XB_XGEN(j)  (2304 + 64 * (j))
#define XB_TOP      3328
#define XB_TOPGEN   3392
#define XCD_BAR_WORDS 3456
#define XB_SPIN_CAP (1u << 18)
#define XLAS __attribute__((address_space(3)))
DEVINL unsigned xb_ld(unsigned* p)              { return __hip_atomic_load(p, __ATOMIC_RELAXED, __HIP_MEMORY_SCOPE_AGENT); }
DEVINL unsigned xb_add(unsigned* p, unsigned v) { return __hip_atomic_fetch_add(p, v, __ATOMIC_RELAXED, __HIP_MEMORY_SCOPE_AGENT); }
DEVINL unsigned xb_xcc_id() { return (unsigned)__builtin_amdgcn_s_getreg((3 << 11) | 20) & 0xFu; }
#define XB_SPIN(cond, bar) do { unsigned _sp = 0; while (cond) { __builtin_amdgcn_s_sleep(1); \
    if ((++_sp & 255u) == 0u) { if (xb_ld(&(bar)[XB_TMO])) break; if (_sp > XB_SPIN_CAP) { atomicAdd(&(bar)[XB_TMO], 1u); break; } } } } while (0)
struct XcdBarrier { unsigned* bar; unsigned x; volatile XLAS unsigned* st; int wave; };
DEVINL XcdBarrier xcd_barrier_post(int wave, unsigned* bar, volatile XLAS unsigned* st) {
    XcdBarrier b; b.bar = bar; b.x = xb_xcc_id(); b.st = st; b.wave = wave;
    if (otid(wave) == 0) (void)xb_add(&bar[XB_XCNT(b.x)], 1u);
    return b;
}
DEVINL void xcd_barrier_complete(unsigned* bar, unsigned x, unsigned& nloc, unsigned& nx) {
    const unsigned G = gridDim.x * gridDim.y * gridDim.z;
    unsigned sum, cnt, mine, sp = 0u;
    for (;;) {
        sum = 0u; cnt = 0u; mine = 0u;
#pragma unroll
        for (unsigned j = 0; j < 16; ++j) { const unsigned c = xb_ld(&bar[XB_XCNT(j)]); sum += c; cnt += (c > 0u) ? 1u : 0u; mine = (j == x) ? c : mine; }
        if (sum == G) break;
        __builtin_amdgcn_s_sleep(1);
        if ((++sp & 255u) == 0u) { if (xb_ld(&bar[XB_TMO])) break; if (sp > XB_SPIN_CAP) { atomicAdd(&bar[XB_TMO], 1u); break; } }
    }
    nloc = mine > 0u ? mine : 1u; nx = cnt > 0u ? cnt : 1u;
}
DEVINL void xcd_barrier(const Params& p, unsigned char* smem) {
    XcdBarrier b; b.bar = (unsigned*)(p.ws + OFF_BAR); b.x = xb_xcc_id(); b.st = (volatile XLAS unsigned*)(XLAS unsigned char*)(smem + 131072); b.wave = p.wave;
    asm volatile("s_waitcnt vmcnt(0)" ::: "memory");
    __syncthreads();
    if (otid(b.wave) == 0) {
        unsigned* bar = b.bar;
        __builtin_amdgcn_s_waitcnt(0);
        unsigned nloc = b.st[0], nx = b.st[1];
        if (nloc == 0u) { xcd_barrier_complete(bar, b.x, nloc, nx); b.st[0] = nloc; b.st[1] = nx; }
        const unsigned old = xb_add(&bar[XB_XSUB(b.x)], 1u);
        const unsigned gen = old / nloc;
        if (old + 1u == (gen + 1u) * nloc) {
            __builtin_amdgcn_fence(__ATOMIC_RELEASE, "agent");
            asm volatile("s_waitcnt vmcnt(0)" ::: "memory");
            const unsigned og = xb_add(&bar[XB_TOP], 1u);
            const unsigned tg = og / nx;
            if (og + 1u == (tg + 1u) * nx) xb_add(&bar[XB_TOPGEN], 1u);
            else XB_SPIN(xb_ld(&bar[XB_TOPGEN]) == tg, bar);
            __builtin_amdgcn_fence(__ATOMIC_ACQUIRE, "agent");
            xb_add(&bar[XB_XGEN(b.x)], 1u);
            asm volatile("s_waitcnt vmcnt(0)" ::: "memory");
        } else {
            XB_SPIN(xb_ld(&bar[XB_XGEN(b.x)]) == gen, bar);
            __builtin_amdgcn_fence(__ATOMIC_ACQUIRE, "agent");
            asm volatile("s_waitcnt vmcnt(0)" ::: "memory");
        }
    }
    __syncthreads();
}

DEVINL void phase_lnmod(const Params& p, bool from_input, bool do_ln, int lnl, int lnj, int ml, int mj,
                        bf16_t* H, bool final_out, bool skipctx = false) {
  char* ws = p.ws;
  float* X = (float*)(ws + OFF_X);
  const float* Mod = (const float*)(ws + OFF_MOD);
  const int lane = otid(p.wave) & 63, wid = otid(p.wave) >> 6;
  const int gw = blockIdx.x * 8 + wid, nw = gridDim.x * 8;
  const float* g = p.in[6] + (size_t)(lnl * 3 + lnj) * 1024;
  const float* bb = p.in[7] + (size_t)(lnl * 3 + lnj) * 1024;
  for (int row0 = gw; row0 < MROWS; row0 += 3 * nw) {
    float4 v[3][4];
    bool ok[3]; int rb[3], rpos[3];
#pragma unroll
    for (int r = 0; r < 3; ++r) {
      const int row = row0 + r * nw;
      ok[r] = row < MROWS;
      rb[r] = row / SEQT; rpos[r] = row - rb[r] * SEQT;
      if (skipctx && rpos[r] < 256) ok[r] = false;
      if (ok[r]) {
        const float* src;
        if (from_input) src = (rpos[r] < 256) ? (p.in[2] + (size_t)(rb[r] * 256 + rpos[r]) * 1024) : (p.in[0] + (size_t)(rb[r] * 2048 + rpos[r] - 256) * 1024);
        else src = X + (size_t)row * 1024;
#pragma unroll
        for (int i = 0; i < 4; ++i) v[r][i] = *(const float4*)(src + i * 256 + lane * 4);
      } else {
#pragma unroll
        for (int i = 0; i < 4; ++i) v[r][i] = make_float4(0.f, 0.f, 0.f, 0.f);
      }
    }
#pragma unroll
    for (int r = 0; r < 3; ++r) {
      if (!ok[r]) continue;
      const int row = row0 + r * nw;
      const int b = rb[r], pos = rpos[r];
      const int mr = pos < 256 ? 16 : b;
      if (do_ln) {
        float s = 0.f;
#pragma unroll
        for (int i = 0; i < 4; ++i) s += v[r][i].x + v[r][i].y + v[r][i].z + v[r][i].w;
        float mean = wave_sum(s) * (1.f / 1024.f);
        float q = 0.f;
#pragma unroll
        for (int i = 0; i < 4; ++i) {
          v[r][i].x -= mean; v[r][i].y -= mean; v[r][i].z -= mean; v[r][i].w -= mean;
          q += v[r][i].x * v[r][i].x + v[r][i].y * v[r][i].y + v[r][i].z * v[r][i].z + v[r][i].w * v[r][i].w;
        }
        float rs = rsqrtf(wave_sum(q) * (1.f / 1024.f) + 1e-5f);
#pragma unroll
        for (int i = 0; i < 4; ++i) {
          float4 gg = *(const float4*)(g + i * 256 + lane * 4);
          float4 b4 = *(const float4*)(bb + i * 256 + lane * 4);
          v[r][i].x = v[r][i].x * rs * gg.x + b4.x; v[r][i].y = v[r][i].y * rs * gg.y + b4.y;
          v[r][i].z = v[r][i].z * rs * gg.z + b4.z; v[r][i].w = v[r][i].w * rs * gg.w + b4.w;
        }
      }
      if (final_out) {
        if (pos >= 256) {
          float* o = p.out + (size_t)(b * 2048 + pos - 256) * 1024;
#pragma unroll
          for (int i = 0; i < 4; ++i) *(float4*)(o + i * 256 + lane * 4) = v[r][i];
        }
      } else {
        const float* sh = Mod + (size_t)(ml * 17 + mr) * 9216 + mj * 1024;
        const float* sc = sh + 1024;
#pragma unroll
        for (int i = 0; i < 4; ++i) {
          if (from_input || do_ln) *(float4*)(X + (size_t)row * 1024 + i * 256 + lane * 4) = v[r][i];
          float4 s4 = *(const float4*)(sh + i * 256 + lane * 4);
          float4 c4 = *(const float4*)(sc + i * 256 + lane * 4);
          uint2 pk;
          pk.x = pk2(v[r][i].x * (1.f + c4.x) + s4.x, v[r][i].y * (1.f + c4.y) + s4.y);
          pk.y = pk2(v[r][i].z * (1.f + c4.z) + s4.z, v[r][i].w * (1.f + c4.w) + s4.w);
          *(uint2*)(H + (size_t)row * 1024 + i * 256 + lane * 4) = pk;
        }
      }
    }
  }
}

DEVINL void phase_ada_partial(const Params& p, float* smf) {
  float* MODP = (float*)(p.ws + OFF_AR + AR_MODP);
  const int tid = otid(p.wave) & 255, half = otid(p.wave) >> 8;
  float* sm = smf + half * 5120;
  for (int it0 = blockIdx.x * 2; it0 < 576; it0 += gridDim.x * 2) {
    int it = it0 + half; bool valid = it < 576; if (!valid) it = 575;
    int kq = it & 3, cb = it >> 2;
    int col = cb * 256 + tid;
    int l = col / 9216, n = col - l * 9216;
    for (int idx = tid; idx < 256 * 17; idx += 256) {
      int r = idx >> 8, k = idx & 255;
      float val = (r < 16) ? p.in[1][r * 1024 + kq * 256 + k] : p.in[3][kq * 256 + k];
      sm[k * 20 + r] = silu(val);
    }
    __syncthreads();
    float acc[17];
#pragma unroll
    for (int r = 0; r < 17; ++r) acc[r] = 0.f;
    const float* w = p.in[4] + ((size_t)l * 1024 + kq * 256) * 9216 + n;
#pragma unroll 4
    for (int k = 0; k < 256; ++k) {
      float wv = w[(size_t)k * 9216];
      const float4* s4 = (const float4*)(sm + k * 20);
      float4 a0 = s4[0], a1 = s4[1], a2 = s4[2], a3 = s4[3];
      float a16 = sm[k * 20 + 16];
      acc[0] += a0.x * wv; acc[1] += a0.y * wv; acc[2] += a0.z * wv; acc[3] += a0.w * wv;
      acc[4] += a1.x * wv; acc[5] += a1.y * wv; acc[6] += a1.z * wv; acc[7] += a1.w * wv;
      acc[8] += a2.x * wv; acc[9] += a2.y * wv; acc[10] += a2.z * wv; acc[11] += a2.w * wv;
      acc[12] += a3.x * wv; acc[13] += a3.y * wv; acc[14] += a3.z * wv; acc[15] += a3.w * wv;
      acc[16] += a16 * wv;
    }
    if (valid) {
#pragma unroll
      for (int r = 0; r < 17; ++r) MODP[((size_t)(kq * 4 + l) * 17 + r) * 9216 + n] = acc[r];
    }
    __syncthreads();
  }
}

DEVINL void phase_ada_reduce(const Params& p) {
  const float* MODP = (const float*)(p.ws + OFF_AR + AR_MODP);
  float* Mod = (float*)(p.ws + OFF_MOD);
  const int total = 4 * 17 * 9216;
  for (int idx = blockIdx.x * 512 + otid(p.wave); idx < total; idx += gridDim.x * 512) {
    int n = idx % 9216; int l = idx / (17 * 9216);
    float s = p.in[5][l * 9216 + n];
#pragma unroll
    for (int kq = 0; kq < 4; ++kq) s += MODP[(size_t)kq * total + idx];
    Mod[idx] = s;
  }
}

DEVINL void phase_tables(const Params& p) {
  float* TAB = (float*)(p.ws + OFF_TAB);
  int idx = blockIdx.x * 512 + otid(p.wave);
  if (idx < 1024) {
    int n = idx >> 4, j = idx & 15;
    float inv = powf(10000.f, -(float)j / 16.f);
    float ang = (float)n * inv;
    TAB[idx] = cosf(ang);
    TAB[1024 + idx] = sinf(ang);
  } else if (idx < 1280) {
    int c = idx - 1024;
    const float* lg = p.in[33];
    float v0 = lg[c], v1 = lg[256 + c], v2 = lg[512 + c], v3 = lg[768 + c];
    float mx = fmaxf(fmaxf(v0, v1), fmaxf(v2, v3));
    float e0 = expf(v0 - mx), e1 = expf(v1 - mx), e2 = expf(v2 - mx), e3 = expf(v3 - mx);
    float inv = 1.f / (e0 + e1 + e2 + e3);
    float s0 = e0 * inv, s1 = e1 * inv, s2 = e2 * inv, s3 = e3 * inv;
    float c0 = s0, c1 = c0 + s1, c2 = c1 + s2, c3 = c2 + s3;
    TAB[2048 + c] = c0 - s0;
    TAB[2048 + 256 + c] = c1 - s0;
    TAB[2048 + 512 + c] = c2 - s0;
    TAB[2048 + 768 + c] = c3 - s0;
  }
}


struct F4 { float a, b, c, d; };
DEVINL F4 ld4bf(const bf16_t* p) { uint2 r = *(const uint2*)p; F4 o; o.a = __uint_as_float(r.x << 16); o.b = __uint_as_float(r.x & 0xffff0000u); o.c = __uint_as_float(r.y << 16); o.d = __uint_as_float(r.y & 0xffff0000u); return o; }
DEVINL void st4bf(bf16_t* p, float a, float b, float c, float d) { uint2 r; r.x = pk2(a, b); r.y = pk2(c, d); *(uint2*)p = r; }
DEVINL F4 ld4f(const float* p) { float4 r = *(const float4*)p; F4 o; o.a = r.x; o.b = r.y; o.c = r.z; o.d = r.w; return o; }
DEVINL float row16_sum(float x) {
  x += __int_as_float(__builtin_amdgcn_update_dpp(0, __float_as_int(x), 0xB1, 0xF, 0xF, true));
  x += __int_as_float(__builtin_amdgcn_update_dpp(0, __float_as_int(x), 0x4E, 0xF, 0xF, true));
  x += __int_as_float(__builtin_amdgcn_update_dpp(0, __float_as_int(x), 0x141, 0xF, 0xF, true));
  x += __int_as_float(__builtin_amdgcn_update_dpp(0, __float_as_int(x), 0x140, 0xF, 0xF, true));
  return x;
}
DEVINL void phase_shift(const Params& p, int l) {
  char* ws = p.ws;
  const bf16_t* PRWp = (const bf16_t*)(ws + OFF_AR + AR_PRW);
  bf16_t* RKV = (bf16_t*)(ws + OFF_AR + AR_RKV);
  bf16_t* A2 = (bf16_t*)(ws + OFF_AR + AR_A2);
  const float* mu = p.in[12] + (size_t)l * PRW;
  bf16_t* PRp = (bf16_t*)(ws + OFF_AR + AR_PREST);
  const float* TABp = (const float*)(ws + OFF_TAB);
  const int lane = otid(p.wave) & 63, wid = otid(p.wave) >> 6;
  const int gw = blockIdx.x * 8 + wid, nw = gridDim.x * 8;
  const int c4 = lane * 4;
  for (int row = gw; row < MROWS; row += nw) {
    int b = row / SEQT, pos = row - b * SEQT;
    const bool hasp = !(pos == 0 || pos == 256);
    const bool hasn = !(pos == 255 || pos == 2303);
    const bf16_t* pr = PRWp + (size_t)row * PRW;
#pragma unroll
    for (int it = 0; it < 5; ++it) {
      const int c = it * 256 + c4;
      if (it < 4 || lane < 8) {
        F4 x0 = ld4bf(pr + c);
        F4 xp = {0.f, 0.f, 0.f, 0.f}, xn = {0.f, 0.f, 0.f, 0.f};
        if (hasp) xp = ld4bf(pr + c - PRW);
        if (hasn) xn = ld4bf(pr + c + PRW);
        F4 m = ld4f(mu + c);
        float s0 = x0.a + m.a * (0.5f * (xp.a + xn.a) - x0.a);
        float s1 = x0.b + m.b * (0.5f * (xp.b + xn.b) - x0.b);
        float s2 = x0.c + m.c * (0.5f * (xp.c + xn.c) - x0.c);
        float s3 = x0.d + m.d * (0.5f * (xp.d + xn.d) - x0.d);
        if (it < 3) {
          st4bf(RKV + (size_t)row * 1024 + c, s0, s1, s2, s3);
          if (it == 1) {
            F4 kc = ld4f(p.in[18] + l * 256 + (c - 256));
            float k0 = s0 * kc.a, k1 = s1 * kc.b, k2 = s2 * kc.c, k3 = s3 * kc.d;
            float nrm = row16_sum(k0 * k0 + k1 * k1 + k2 * k2 + k3 * k3);
            float rs = rsqrtf(fmaxf(nrm, 1e-12f));
            st4bf(RKV + (size_t)row * 1024 + 512 + c, k0 * rs, k1 * rs, k2 * rs, k3 * rs);
          }
        } else if (c < 832) st4bf(A2 + (size_t)row * 384 + (c - 768), tanh_fast(s0), tanh_fast(s1), tanh_fast(s2), tanh_fast(s3));
        else if (c < 896) st4bf(A2 + (size_t)row * 384 + (c - 768), s0, s1, s2, s3);
        else st4bf(A2 + (size_t)row * 384 + 128 + (c - 896), sigm(s0), sigm(s1), sigm(s2), sigm(s3));
      }
    }
    if (lane < 24) *(uint2*)(A2 + (size_t)row * 384 + 288 + c4) = make_uint2(0u, 0u);
    {
      bf16_t* prr = PRp + (size_t)row * PREST;
      const int d = c4 & 63, jj = d & 31, fi = jj & 15;
      F4 cs = {1.f, 1.f, 1.f, 1.f}, sn = {0.f, 0.f, 0.f, 0.f};
      if (pos >= 256) {
        const int t = pos - 256; const int n = jj < 16 ? (t >> 6) : (t & 63);
        cs = ld4f(TABp + n * 16 + fi); sn = ld4f(TABp + 1024 + n * 16 + fi);
      }
      const int cp = c4 ^ 32;
      F4 xq = ld4bf(prr + c4), xqp = ld4bf(prr + cp), xk = ld4bf(prr + 256 + c4), xkp = ld4bf(prr + 256 + cp);
      const float sg = (d < 32) ? -1.f : 1.f;
      asm volatile("" ::: "memory");
      st4bf(prr + c4, xq.a * cs.a + sg * xqp.a * sn.a, xq.b * cs.b + sg * xqp.b * sn.b, xq.c * cs.c + sg * xqp.c * sn.c, xq.d * cs.d + sg * xqp.d * sn.d);
      st4bf(prr + 256 + c4, 0.125f * (xk.a * cs.a + sg * xkp.a * sn.a), 0.125f * (xk.b * cs.b + sg * xkp.b * sn.b),
            0.125f * (xk.c * cs.c + sg * xkp.c * sn.c), 0.125f * (xk.d * cs.d + sg * xkp.d * sn.d));
      F4 lb = ld4f(TABp + 2048 + l * 256 + c4);
      F4 zf = ld4bf(prr + 1536 + c4), zb = ld4bf(prr + 1792 + c4);
      F4 f0 = ld4f(p.in[34] + (l * 2 + 0) * 256 + c4), f1 = ld4f(p.in[34] + (l * 2 + 1) * 256 + c4);
      st4bf(prr + 1536 + c4, (1.f - lb.a) * sigm(-(zf.a + f0.a)), (1.f - lb.b) * sigm(-(zf.b + f0.b)), (1.f - lb.c) * sigm(-(zf.c + f0.c)), (1.f - lb.d) * sigm(-(zf.d + f0.d)));
      st4bf(prr + 1792 + c4, (1.f - lb.a) * sigm(-(zb.a + f1.a)), (1.f - lb.b) * sigm(-(zb.b + f1.b)), (1.f - lb.c) * sigm(-(zb.c + f1.c)), (1.f - lb.d) * sigm(-(zb.d + f1.d)));
    }
  }
}

DEVINL int vrow(int b, int dir, int pp) {
  int pos = dir ? (pp < 256 ? 255 - pp : 2559 - pp) : pp;
  return b * SEQT + pos;
}

typedef float v2f __attribute__((ext_vector_type(2)));
#ifdef NOSB
#define SB()
#else
#define SB() __builtin_amdgcn_sched_barrier(0)
#endif
#define LO2(t) __builtin_shufflevector(t, t, 0, 1)
#define HI2(t) __builtin_shufflevector(t, t, 2, 3)
DEVINL void wave_lds_sync() {
  __builtin_amdgcn_fence(__ATOMIC_RELEASE, "wavefront");
  __builtin_amdgcn_wave_barrier();
  __builtin_amdgcn_fence(__ATOMIC_ACQUIRE, "wavefront");
}

DEVINL float dpp_xor1(float x) { return __int_as_float(__builtin_amdgcn_update_dpp(0, __float_as_int(x), 0xB1, 0xF, 0xF, true)); }
DEVINL float dpp_xor2(float x) { return __int_as_float(__builtin_amdgcn_update_dpp(0, __float_as_int(x), 0x4E, 0xF, 0xF, true)); }

typedef _Float16 h2 __attribute__((ext_vector_type(2)));
typedef _Float16 h8 __attribute__((ext_vector_type(8)));
#define H2(q, j) (h2{(q)[2 * (j)], (q)[2 * (j) + 1]})
DEVINL void scan_rwkv(const Params& p, int l, int b, int dir, int h, int quarter, int lane, float* sw) {
  asm volatile("" : "+v"(lane));
  __builtin_amdgcn_s_setprio(3);
  char* ws = p.ws;
  const bf16_t* RKV = (const bf16_t*)(ws + OFF_AR + AR_RKV);
  const bf16_t* L = (const bf16_t*)(ws + OFF_AR + AR_L);
  bf16_t* O = (bf16_t*)(ws + OFF_AR + AR_OUT) + (size_t)(dir ? 4 : 0) * OUTSLOT;
  const int c = h * 64 + lane;
  const int kp = lane & 3, myrow = quarter * 16 + (lane >> 2);
  const float kac = p.in[19][l * 256 + c];
  h2 S[8];
#pragma unroll
  for (int k = 0; k < 8; ++k) S[k] = h2{(_Float16)0.f, (_Float16)0.f};
  bf16_t rr[8], rk[8], rv[8], rkk[8], rw[8], ra[8];
#define RWKV_LOADRAW(CH)                                                  \
  _Pragma("unroll") for (int s = 0; s < 8; ++s) {                         \
    int row = vrow(b, dir, (CH) * 8 + s);                                 \
    rr[s] = RKV[(size_t)row * 1024 + c];                                  \
    rk[s] = RKV[(size_t)row * 1024 + 256 + c];                            \
    rv[s] = RKV[(size_t)row * 1024 + 512 + c];                            \
    rkk[s] = RKV[(size_t)row * 1024 + 768 + c];                           \
    rw[s] = L[(size_t)row * 1280 + dir * 256 + c];                        \
    ra[s] = L[(size_t)row * 1280 + 512 + dir * 256 + c];                  \
  }
#define RWKV_LD(Q, VV, S_)                                                              \
  { const float* base_ = sw + (S_) * 224;                                               \
    _Pragma("unroll") for (int a = 0; a < 5; ++a) {                                     \
      Q[2 * a] = *(const h8*)(base_ + a * 32 + kp * 8);                                 \
      Q[2 * a + 1] = *(const h8*)(base_ + a * 32 + kp * 8 + 4); }                       \
    VV = base_[160 + myrow]; }
#define RWKV_CMP(Q, VV, S_)                                                             \
  { h2 sa0 = h2{(_Float16)0.f, (_Float16)0.f}, sa1 = sa0;                               \
    _Pragma("unroll") for (int i = 0; i < 4; ++i) { sa0 += S[i] * H2(Q[0], i); sa1 += S[4 + i] * H2(Q[1], i); } \
    float sa = ((float)sa0.x + (float)sa0.y) + ((float)sa1.x + (float)sa1.y);           \
    sa += dpp_xor1(sa); sa += dpp_xor2(sa);                                             \
    const h2 sasa = h2{(_Float16)sa, (_Float16)sa}, vv = h2{(_Float16)(VV), (_Float16)(VV)}; \
    h2 y0 = h2{(_Float16)0.f, (_Float16)0.f}, y1 = y0;                                  \
    _Pragma("unroll") for (int g = 0; g < 2; ++g) _Pragma("unroll") for (int i = 0; i < 4; ++i) { \
      const h2 nw = H2(Q[2 + g], i), bq = H2(Q[4 + g], i), dq = H2(Q[6 + g], i), rq = H2(Q[8 + g], i); \
      const h2 t = vv * dq - sasa * bq;                                                 \
      const h2 u = S[4 * g + i] + t;                                                    \
      S[4 * g + i] = S[4 * g + i] * nw + u;                                             \
      if (g == 0) y0 += S[4 * g + i] * rq; else y1 += S[4 * g + i] * rq;                \
    }                                                                                   \
    float y = ((float)y0.x + (float)y0.y) + ((float)y1.x + (float)y1.y);                \
    y += dpp_xor1(y); y += dpp_xor2(y);                                                 \
    if (kp == 0) { int row = vrow(b, dir, ch * 8 + (S_)); O[(size_t)row * 256 + h * 64 + myrow] = f2bf(y); } }
  RWKV_LOADRAW(0)
#pragma unroll 1
  for (int ch = 0; ch < 288; ++ch) {
#pragma unroll
    for (int s = 0; s < 8; ++s) {
      float r_ = bf2f(rr[s]), k_ = bf2f(rk[s]), v_ = bf2f(rv[s]), kk_ = bf2f(rkk[s]);
      float omw = bf2f(rw[s]), a_ = bf2f(ra[s]);
      float kd_ = k_ * (1.f + (a_ - 1.f) * kac);
      _Float16* q = (_Float16*)(sw + s * 224);
      q[lane] = (_Float16)kk_; q[64 + lane] = (_Float16)(-omw); q[128 + lane] = (_Float16)(kk_ * a_); q[192 + lane] = (_Float16)kd_; q[256 + lane] = (_Float16)r_;
      sw[s * 224 + 160 + lane] = v_;
    }
    wave_lds_sync();
    if (ch + 1 < 288) { RWKV_LOADRAW(ch + 1) }
    SB();
    h8 QA[10], QB[10]; float vA, vB;
    RWKV_LD(QA, vA, 0) SB();
    RWKV_LD(QB, vB, 1) SB(); RWKV_CMP(QA, vA, 0) SB();
    RWKV_LD(QA, vA, 2) SB(); RWKV_CMP(QB, vB, 1) SB();
    RWKV_LD(QB, vB, 3) SB(); RWKV_CMP(QA, vA, 2) SB();
    RWKV_LD(QA, vA, 4) SB(); RWKV_CMP(QB, vB, 3) SB();
    RWKV_LD(QB, vB, 5) SB(); RWKV_CMP(QA, vA, 4) SB();
    RWKV_LD(QA, vA, 6) SB(); RWKV_CMP(QB, vB, 5) SB();
    RWKV_LD(QB, vB, 7) SB(); RWKV_CMP(QA, vA, 6) SB();
    RWKV_CMP(QB, vB, 7) SB();
    wave_lds_sync();
  }
  __builtin_amdgcn_s_setprio(0);
#undef RWKV_LOADRAW
#undef RWKV_LD
#undef RWKV_CMP
}

template <int MODE>
DEVINL void scan_gla(const Params& p, int l, int b, int dir, int h, int quarter, int lane, float* sw) {
  asm volatile("" : "+v"(lane));
  __builtin_amdgcn_s_setprio(3);
  char* ws = p.ws;
  const bf16_t* PR = (const bf16_t*)(ws + OFF_AR + AR_PREST);
  bf16_t* O = (bf16_t*)(ws + OFF_AR + AR_OUT) + (size_t)(MODE == 0 ? (dir ? 6 : 3) : (dir ? 5 : 1)) * OUTSLOT;
  const int c = h * 64 + lane;
  const int dp = lane & 3, mycol = quarter * 16 + (lane >> 2);
  const float gamma = 1.f - exp2f(-5.f - (float)h);
  const h2 g2 = h2{(_Float16)gamma, (_Float16)gamma};
  h2 S[8];
#pragma unroll
  for (int k = 0; k < 8; ++k) S[k] = h2{(_Float16)0.f, (_Float16)0.f};
  bf16_t r0[8], r1[8], r2[8];
  const int cA = (MODE == 0) ? ((dir ? 1792 : 1536) + c) : (256 + c);
  const int cQ = (MODE == 0) ? (1280 + c) : c;
  const int cV = (MODE == 0) ? (2048 + c) : (512 + c);
#define GLA_LOADRAW(CH)                                                              \
  _Pragma("unroll") for (int s = 0; s < 8; ++s) {                                    \
    int row = vrow(b, dir, (CH) * 8 + s);                                            \
    const bf16_t* pr = PR + (size_t)row * PREST;                                     \
    r0[s] = pr[cA]; r1[s] = pr[cQ]; r2[s] = pr[cV];                                  \
  }
#define GLA_LD(Q, VV, S_)                                                            \
  { const float* base_ = sw + (S_) * 128;                                            \
    Q[0] = *(const h8*)(base_ + dp * 8); Q[1] = *(const h8*)(base_ + dp * 8 + 4);    \
    Q[2] = *(const h8*)(base_ + 32 + dp * 8); Q[3] = *(const h8*)(base_ + 32 + dp * 8 + 4); \
    VV = base_[64 + mycol]; }
#define GLA_CMP(Q, VV, S_)                                                           \
  { const h2 vv = h2{(_Float16)(VV), (_Float16)(VV)}; h2 o0 = h2{(_Float16)0.f, (_Float16)0.f}, o1 = o0; \
    _Pragma("unroll") for (int g_ = 0; g_ < 2; ++g_) _Pragma("unroll") for (int i = 0; i < 4; ++i) { \
      const h2 a2 = H2(Q[g_], i), q2 = H2(Q[2 + g_], i);                             \
      if (MODE == 0) {                      \
        S[4 * g_ + i] = S[4 * g_ + i] - a2 * (S[4 * g_ + i] - vv);                   \
        if (g_ == 0) o0 += S[4 * g_ + i] * q2; else o1 += S[4 * g_ + i] * q2;        \
      } else {                                                                       \
        if (dir) { if (g_ == 0) o0 += S[4 * g_ + i] * q2; else o1 += S[4 * g_ + i] * q2; } \
        S[4 * g_ + i] = g2 * S[4 * g_ + i] + a2 * vv;                                \
        if (!dir) { if (g_ == 0) o0 += S[4 * g_ + i] * q2; else o1 += S[4 * g_ + i] * q2; } \
      }                                                                              \
    }                                                                                \
    float o = ((float)o0.x + (float)o0.y) + ((float)o1.x + (float)o1.y);             \
    o += dpp_xor1(o); o += dpp_xor2(o);                                              \
    if (dp == 0) { int row = vrow(b, dir, ch * 8 + (S_)); O[(size_t)row * 256 + h * 64 + mycol] = f2bf(o); } }
  GLA_LOADRAW(0)
#pragma unroll 1
  for (int ch = 0; ch < 288; ++ch) {
#pragma unroll
    for (int s = 0; s < 8; ++s) {
      _Float16* q = (_Float16*)(sw + s * 128);
      q[lane] = (_Float16)bf2f(r0[s]); q[64 + lane] = (_Float16)bf2f(r1[s]);
      sw[s * 128 + 64 + lane] = bf2f(r2[s]);
    }
    wave_lds_sync();
    if (ch + 1 < 288) { GLA_LOADRAW(ch + 1) }
    SB();
    h8 QA[4], QB[4]; float vA, vB;
    GLA_LD(QA, vA, 0) SB();
    GLA_LD(QB, vB, 1) SB(); GLA_CMP(QA, vA, 0) SB();
    GLA_LD(QA, vA, 2) SB(); GLA_CMP(QB, vB, 1) SB();
    GLA_LD(QB, vB, 3) SB(); GLA_CMP(QA, vA, 2) SB();
    GLA_LD(QA, vA, 4) SB(); GLA_CMP(QB, vB, 3) SB();
    GLA_LD(QB, vB, 5) SB(); GLA_CMP(QA, vA, 4) SB();
    GLA_LD(QA, vA, 6) SB(); GLA_CMP(QB, vB, 5) SB();
    GLA_LD(QB, vB, 7) SB(); GLA_CMP(QA, vA, 6) SB();
    GLA_CMP(QB, vB, 7) SB();
    wave_lds_sync();
  }
  __builtin_amdgcn_s_setprio(0);
#undef GLA_LOADRAW
#undef GLA_LD
#undef GLA_CMP
}

DEVINL void scan_s5(const Params& p, int l, int b, int dir, int g, int lane, float* smC) {
  asm volatile("" : "+v"(lane));
  char* ws = p.ws;
  const bf16_t* PR = (const bf16_t*)(ws + OFF_AR + AR_PREST);
  bf16_t* O = (bf16_t*)(ws + OFF_AR + AR_OUT) + (size_t)(dir ? 7 : 8) * OUTSLOT;
  _Float16* hC = (_Float16*)smC;
  _Float16* hS = (_Float16*)(smC + 1024);
  float* smU = smC + 2048;
  const size_t gi = (size_t)((l * 2 + dir) * 16 + g);
  float lbr, lbi; h2 bb[16];
  {
    float lr = p.in[23][gi * 64 + lane], li = p.in[24][gi * 64 + lane];
    float dt = expf(p.in[25][gi]);
    float mag = expf(lr * dt);
    lbr = mag * cosf(li * dt); lbi = mag * sinf(li * dt);
    float den = lr * lr + li * li;
    float fre = ((lbr - 1.f) * lr + lbi * li) / den;
    float fim = (lbi * lr - (lbr - 1.f) * li) / den;
    const float* br = p.in[26] + (gi * 64 + lane) * 16;
    const float* bi = p.in[27] + (gi * 64 + lane) * 16;
#pragma unroll
    for (int i = 0; i < 16; ++i) {
      float r_ = br[i], i_ = bi[i];
      bb[i] = h2{(_Float16)(fre * r_ - fim * i_), (_Float16)(fre * i_ + fim * r_)};
    }
    const float* cr = p.in[28] + gi * 1024;
    const float* ci = p.in[29] + gi * 1024;
#pragma unroll
    for (int o = 0; o < 16; ++o) {
      hC[(o * 2 + 0) * 64 + lane] = (_Float16)cr[o * 64 + lane];
      hC[(o * 2 + 1) * 64 + lane] = (_Float16)ci[o * 64 + lane];
    }
  }
  float sre = 0.f, sim = 0.f;
  const int ts = lane >> 2, i4 = lane & 3;
  uint2 raw = *(const uint2*)(PR + (size_t)vrow(b, dir, ts) * PREST + 1024 + g * 16 + i4 * 4);
#pragma unroll 1
  for (int ch = 0; ch < 144; ++ch) {
    {
      h2 d0, d1, d2, d3;
      _Float16 u0 = (_Float16)bf2f((bf16_t)(raw.x & 0xffff)), u1 = (_Float16)bf2f((bf16_t)(raw.x >> 16));
      _Float16 u2 = (_Float16)bf2f((bf16_t)(raw.y & 0xffff)), u3 = (_Float16)bf2f((bf16_t)(raw.y >> 16));
      d0 = h2{u0, u0}; d1 = h2{u1, u1}; d2 = h2{u2, u2}; d3 = h2{u3, u3};
      h8 pk = h8{d0.x, d0.y, d1.x, d1.y, d2.x, d2.y, d3.x, d3.y};
      *(h8*)(smU + ts * 16 + i4 * 4) = pk;
    }
    wave_lds_sync();
    if (ch + 1 < 144) raw = *(const uint2*)(PR + (size_t)vrow(b, dir, (ch + 1) * 16 + ts) * PREST + 1024 + g * 16 + i4 * 4);
#pragma unroll 4
    for (int s = 0; s < 16; ++s) {
      const h8* u = (const h8*)(smU + s * 16);
      h8 u0 = u[0], u1 = u[1], u2 = u[2], u3 = u[3];
      h2 a0 = bb[0] * H2(u0, 0), a1 = bb[1] * H2(u0, 1);
      a0 += bb[2] * H2(u0, 2); a1 += bb[3] * H2(u0, 3);
      a0 += bb[4] * H2(u1, 0); a1 += bb[5] * H2(u1, 1);
      a0 += bb[6] * H2(u1, 2); a1 += bb[7] * H2(u1, 3);
      a0 += bb[8] * H2(u2, 0); a1 += bb[9] * H2(u2, 1);
      a0 += bb[10] * H2(u2, 2); a1 += bb[11] * H2(u2, 3);
      a0 += bb[12] * H2(u3, 0); a1 += bb[13] * H2(u3, 1);
      a0 += bb[14] * H2(u3, 2); a1 += bb[15] * H2(u3, 3);
      const float bur = (float)a0.x + (float)a1.x, bui = (float)a0.y + (float)a1.y;
      float nre = lbr * sre - lbi * sim + bur;
      float nim = lbr * sim + lbi * sre + bui;
      sre = nre; sim = nim;
      hS[(s * 2 + 0) * 64 + lane] = (_Float16)sre;
      hS[(s * 2 + 1) * 64 + lane] = (_Float16)sim;
    }
    wave_lds_sync();
    {
      h2 acc[4];
#pragma unroll
      for (int oo = 0; oo < 4; ++oo) acc[oo] = h2{(_Float16)0.f, (_Float16)0.f};
      const _Float16* sr = hS + (ts * 2 + 0) * 64;
      const _Float16* si = hS + (ts * 2 + 1) * 64;
#pragma unroll 4
      for (int p8 = 0; p8 < 8; ++p8) {
        h8 a = *(const h8*)(sr + p8 * 8), bq = *(const h8*)(si + p8 * 8);
#pragma unroll
        for (int oo = 0; oo < 4; ++oo) {
          int o = i4 * 4 + oo;
          h8 cr8 = *(const h8*)(hC + (o * 2 + 0) * 64 + p8 * 8);
          h8 ci8 = *(const h8*)(hC + (o * 2 + 1) * 64 + p8 * 8);
#pragma unroll
          for (int j = 0; j < 4; ++j) { acc[oo] += H2(cr8, j) * H2(a, j); acc[oo] -= H2(ci8, j) * H2(bq, j); }
        }
      }
      int row = vrow(b, dir, ch * 16 + ts);
      uint2 pk;
      pk.x = (unsigned)f2bf((float)acc[0].x + (float)acc[0].y) | ((unsigned)f2bf((float)acc[1].x + (float)acc[1].y) << 16);
      pk.y = (unsigned)f2bf((float)acc[2].x + (float)acc[2].y) | ((unsigned)f2bf((float)acc[3].x + (float)acc[3].y) << 16);
      *(uint2*)(O + (size_t)row * 256 + g * 16 + i4 * 4) = pk;
    }
    wave_lds_sync();
  }
}

DEVINL void phase_scans(const Params& p, int l, float* smf) {
  const int tid = otid(p.wave), lane = tid & 63, wid = __builtin_amdgcn_readfirstlane(tid >> 6);
  for (int task = blockIdx.x; task < 256; task += gridDim.x) {
    if (wid < 2) {
      const int chain = task >> 1, quarter = (task & 1) * 2 + wid;
      scan_rwkv(p, l, chain >> 3, (chain >> 2) & 1, chain & 3, quarter, lane, smf + wid * 1792);
    } else if (wid < 4) {
      const int t2 = task + (wid - 2) * 256;
      scan_s5(p, l, t2 >> 5, (t2 >> 4) & 1, t2 & 15, lane, smf + 9728 + (wid - 2) * 4352);
    } else {
      const int chain = task & 127, quarter = wid - 4;
      if (task < 128) scan_gla<0>(p, l, chain >> 3, (chain >> 2) & 1, chain & 3, quarter, lane, smf + 3584 + quarter * 1536);
      else scan_gla<1>(p, l, chain >> 3, (chain >> 2) & 1, chain & 3, quarter, lane, smf + 3584 + quarter * 1536);
    }
  }
}

DEVINL void phase_post(const Params& p, int l, bool skipctx = false) {
  char* ws = p.ws;
  bf16_t* OUTp = (bf16_t*)(ws + OFF_AR + AR_OUT);
  const bf16_t* PR = (const bf16_t*)(ws + OFF_AR + AR_PREST);
  const bf16_t* RKV = (const bf16_t*)(ws + OFF_AR + AR_RKV);
  const bf16_t* L = (const bf16_t*)(ws + OFF_AR + AR_L);
  const int lane = otid(p.wave) & 63, wid = otid(p.wave) >> 6;
  const int gw = blockIdx.x * 8 + wid, nw = gridDim.x * 8;
  const int c = lane * 4;
  const F4 gn_a = ld4f(p.in[21] + l * 256 + c), ka = ld4f(p.in[19] + l * 256 + c), rk = ld4f(p.in[20] + l * 256 + c);
  const F4 gn_b = ld4f(p.in[22] + l * 256 + c), dsk = ld4f(p.in[30] + l * 256 + c), gn_d = ld4f(p.in[35] + l * 256 + c);
  for (int row = gw; row < MROWS; row += nw) {
    if (skipctx && (row % SEQT) < 256) continue;
    const size_t ro = (size_t)row * 256 + c;
    {
      F4 y0 = ld4bf(OUTp + 0 * OUTSLOT + ro), y1 = ld4bf(OUTp + 4 * OUTSLOT + ro);
      float a0 = y0.a + y1.a, a1 = y0.b + y1.b, a2 = y0.c + y1.c, a3 = y0.d + y1.d;
      float mean = row16_sum(a0 + a1 + a2 + a3) * (1.f / 64.f);
      a0 -= mean; a1 -= mean; a2 -= mean; a3 -= mean;
      float rs = rsqrtf(row16_sum(a0 * a0 + a1 * a1 + a2 * a2 + a3 * a3) * (1.f / 64.f) + 64e-5f);
      F4 r_ = ld4bf(RKV + (size_t)row * 1024 + c), k_ = ld4bf(RKV + (size_t)row * 1024 + 256 + c), v_ = ld4bf(RKV + (size_t)row * 1024 + 512 + c);
      F4 af = ld4bf(L + (size_t)row * 1280 + 512 + c), ab = ld4bf(L + (size_t)row * 1280 + 768 + c), gg = ld4bf(L + (size_t)row * 1280 + 1024 + c);
      float t = r_.a * k_.a * rk.a * (2.f + (af.a + ab.a - 2.f) * ka.a) + r_.b * k_.b * rk.b * (2.f + (af.b + ab.b - 2.f) * ka.b)
              + r_.c * k_.c * rk.c * (2.f + (af.c + ab.c - 2.f) * ka.c) + r_.d * k_.d * rk.d * (2.f + (af.d + ab.d - 2.f) * ka.d);
      float bs = row16_sum(t);
      st4bf(OUTp + 0 * OUTSLOT + ro, (a0 * rs * gn_a.a + bs * v_.a) * gg.a, (a1 * rs * gn_a.b + bs * v_.b) * gg.b,
            (a2 * rs * gn_a.c + bs * v_.c) * gg.c, (a3 * rs * gn_a.d + bs * v_.d) * gg.d);
    }
    {
      F4 y0 = ld4bf(OUTp + 1 * OUTSLOT + ro), y1 = ld4bf(OUTp + 5 * OUTSLOT + ro);
      float a0 = y0.a + y1.a, a1 = y0.b + y1.b, a2 = y0.c + y1.c, a3 = y0.d + y1.d;
      float mean = row16_sum(a0 + a1 + a2 + a3) * (1.f / 64.f);
      a0 -= mean; a1 -= mean; a2 -= mean; a3 -= mean;
      float rs = rsqrtf(row16_sum(a0 * a0 + a1 * a1 + a2 * a2 + a3 * a3) * (1.f / 64.f) + 1e-5f);
      F4 g = ld4bf(PR + (size_t)row * PREST + 768 + c);
      st4bf(OUTp + 1 * OUTSLOT + ro, a0 * rs * gn_b.a * silu(g.a), a1 * rs * gn_b.b * silu(g.b), a2 * rs * gn_b.c * silu(g.c), a3 * rs * gn_b.d * silu(g.d));
    }
    {
      F4 u = ld4bf(PR + (size_t)row * PREST + 1024 + c);
      F4 y0 = ld4bf(OUTp + 8 * OUTSLOT + ro), y1 = ld4bf(OUTp + 7 * OUTSLOT + ro);
      float e0 = dsk.a * u.a + y0.a + y1.a, e1 = dsk.b * u.b + y0.b + y1.b, e2 = dsk.c * u.c + y0.c + y1.c, e3 = dsk.d * u.d + y0.d + y1.d;
      e0 = 0.5f * e0 * (1.f + tanh_fast(0.7978845608028654f * (e0 + 0.044715f * e0 * e0 * e0)));
      e1 = 0.5f * e1 * (1.f + tanh_fast(0.7978845608028654f * (e1 + 0.044715f * e1 * e1 * e1)));
      e2 = 0.5f * e2 * (1.f + tanh_fast(0.7978845608028654f * (e2 + 0.044715f * e2 * e2 * e2)));
      e3 = 0.5f * e3 * (1.f + tanh_fast(0.7978845608028654f * (e3 + 0.044715f * e3 * e3 * e3)));
      st4bf(OUTp + 8 * OUTSLOT + ro, e0, e1, e2, e3);
    }
    {
      F4 y0 = ld4bf(OUTp + 3 * OUTSLOT + ro), y1 = ld4bf(OUTp + 6 * OUTSLOT + ro);
      float a0 = y0.a + y1.a, a1 = y0.b + y1.b, a2 = y0.c + y1.c, a3 = y0.d + y1.d;
      float rs = rsqrtf(row16_sum(a0 * a0 + a1 * a1 + a2 * a2 + a3 * a3) * (1.f / 64.f) + 1e-5f);
      F4 g = ld4bf(PR + (size_t)row * PREST + 2304 + c);
      st4bf(OUTp + 3 * OUTSLOT + ro, a0 * rs * gn_d.a * silu(g.a), a1 * rs * gn_d.b * silu(g.b), a2 * rs * gn_d.c * silu(g.c), a3 * rs * gn_d.d * silu(g.d));
    }
  }
}

__global__ void __launch_bounds__(512, 2) mega(Params p_in) {
  Params p = p_in;
  p.wave = __builtin_amdgcn_readfirstlane((int)threadIdx.x >> 6);
  cg::grid_group grid = cg::this_grid();
  extern __shared__ __attribute__((aligned(16))) unsigned char smem[];
  float* smf = (float*)smem;
  char* ws = p.ws;

  if (p.ws_size < WS_NEED) {
    for (size_t i = (size_t)blockIdx.x * 512 + otid(p.wave); i < (size_t)NB * 2048 * 1024; i += (size_t)gridDim.x * 512)
      p.out[i] = __uint_as_float(0x7fc00000u);
    return;
  }

  unsigned* barw = (unsigned*)(ws + OFF_BAR);
  volatile XLAS unsigned* xst = (volatile XLAS unsigned*)(XLAS unsigned char*)(smem + 131072);
  if (blockIdx.x == 0) for (int i = otid(p.wave); i < XCD_BAR_WORDS; i += 512) barw[i] = 0u;
  if (otid(p.wave) < 4) xst[otid(p.wave)] = 0u;
  phase_ada_partial(p, smf);
  phase_tables(p);
  grid.sync();
  (void)xcd_barrier_post(p.wave, barw, xst);
  phase_ada_reduce(p);
  xcd_barrier(p, smem);

  float* X = (float*)(ws + OFF_X);
  const float* Mod = (const float*)(ws + OFF_MOD);
  bf16_t* HFFN = (bf16_t*)(ws + OFF_AR + AR_HFFN);
  bf16_t* HMIX = (bf16_t*)(ws + OFF_AR + AR_HMIX);
  bf16_t* HP = (bf16_t*)(ws + OFF_AR + AR_HP);
  bf16_t* U = (bf16_t*)(ws + OFF_AR + AR_U);
  bf16_t* OUTp = (bf16_t*)(ws + OFF_AR + AR_OUT);
  bf16_t* BR = (bf16_t*)(ws + OFF_AR + AR_BR);

  for (int l = 0; l < DEPTH; ++l) {
    if (l == 0) phase_lnmod(p, true, false, 0, 0, 0, 0, HFFN, false);
    else phase_lnmod(p, false, true, l - 1, 2, l, 0, HFFN, false);
    const int idle0 = (576 % (int)gridDim.x);
    if (l == 0) { conv_ffn(p, 0, 0, smf, 0, 1408); }
    xcd_barrier(p, smem);
    run_gemm(p.wave, smem, HFFN, (const bf16_t*)(ws + OFF_W13), MROWS, 5632, 1024, EpiSwiglu{U});
    conv_ffn(p, l, 0, smf, 1408, 2112, 3168 % (int)gridDim.x);
    xcd_barrier(p, smem);
    run_gemm(p.wave, smem, U, (const bf16_t*)(ws + OFF_W2), MROWS, 1024, FF, EpiResid{X, Mod, l, 2, 0.5f});
    conv_mix(p, l, smf, idle0);
    xcd_barrier(p, smem);
    phase_lnmod(p, false, true, l, 0, l, 3, HMIX, false);
    xcd_barrier(p, smem);
    run_gemm(p.wave, smem, HMIX, (const bf16_t*)(ws + OFF_WIN), MROWS, 3840, 1024,
             EpiPin{(bf16_t*)(ws + OFF_AR + AR_PRW), (bf16_t*)(ws + OFF_AR + AR_PREST)});
    xcd_barrier(p, smem);
    phase_shift(p, l);
    xcd_barrier(p, smem);
    run_gemm(p.wave, smem, (const bf16_t*)(ws + OFF_AR + AR_A2), (const bf16_t*)(ws + OFF_WL), MROWS, 1280, 384,
             EpiLora{(bf16_t*)(ws + OFF_AR + AR_L), p.in[13] + l * 512, p.in[15] + l * 512});
    xcd_barrier(p, smem);
    phase_scans(p, l, smf);
    xcd_barrier(p, smem);
    const int last = (l == DEPTH - 1);
    phase_post(p, l, last);
    xcd_barrier(p, smem);
    run_gemm(p.wave, smem, OUTp + 8 * OUTSLOT, (const bf16_t*)(ws + OFF_WGLU), MROWS, 256, 256,
             EpiGlu{OUTp + 8 * OUTSLOT, OUTp + 2 * OUTSLOT, p.in[32] + l * 256}, last);
    phase_lnmod(p, false, false, 0, 0, l, 3, HP, false, last);
    xcd_barrier(p, smem);
    run_gemm<EpiBranch, pg8::BranchOrder>(p.wave, smem, OUTp, (const bf16_t*)(ws + OFF_WB), 4 * MROWS, 1024, 256, EpiBranch{BR}, last);
    xcd_barrier(p, smem);
    run_gemm(p.wave, smem, HP, (const bf16_t*)(ws + OFF_WG), MROWS, 4096, 1024, EpiGate{BR, p.in[38] + (size_t)l * 4096}, last);
    xcd_barrier(p, smem);
    run_gemm(p.wave, smem, BR, (const bf16_t*)(ws + OFF_WO4), MROWS, 1024, 4096, EpiResid{X, Mod, l, 5, 1.0f}, last);
    conv_ffn(p, l, 1, smf, 0, 2112, last ? 0 : idle0);
    xcd_barrier(p, smem);
    phase_lnmod(p, false, true, l, 1, l, 6, HFFN, false, last);
    xcd_barrier(p, smem);
    run_gemm(p.wave, smem, HFFN, (const bf16_t*)(ws + OFF_W13), MROWS, 5632, 1024, EpiSwiglu{U}, last);
    xcd_barrier(p, smem);
    run_gemm(p.wave, smem, U, (const bf16_t*)(ws + OFF_W2), MROWS, 1024, FF, EpiResid{X, Mod, l, 8, 0.5f}, last);
    if (l + 1 < DEPTH) conv_ffn(p, l + 1, 0, smf, 0, 1408, idle0);
    xcd_barrier(p, smem);
  }
  phase_lnmod(p, false, true, DEPTH - 1, 2, 0, 0, HFFN, true, true);
}

extern "C" void kernel_launch(void* const* d_in, const int* in_sizes, int n_in, void* d_out, int out_size,
                              void* d_ws, size_t ws_size, hipStream_t stream) {
  static int grid_blocks = 0;
  if (!grid_blocks) {
    int dev = 0, cus = 0, per_cu = 0;
    (void)hipGetDevice(&dev);
    (void)hipDeviceGetAttribute(&cus, hipDeviceAttributeMultiprocessorCount, dev);
    (void)hipFuncSetAttribute((const void*)mega, hipFuncAttributeMaxDynamicSharedMemorySize, LDS_BYTES);
    (void)hipOccupancyMaxActiveBlocksPerMultiprocessor(&per_cu, mega, 512, LDS_BYTES);
    if (per_cu > 1) per_cu = 1;
    if (per_cu < 1) per_cu = 1;
    grid_blocks = cus * per_cu;
  }
  Params p{};
  for (int i = 0; i < 40; ++i) p.in[i] = (const float*)d_in[i];
  p.out = (float*)d_out;
  p.ws = (char*)d_ws;
  p.ws_size = (unsigned long long)ws_size;
  void* args[] = {&p};
  hipError_t e = hipLaunchCooperativeKernel((void*)mega, dim3(grid_blocks), dim3(512), args, LDS_BYTES, stream);
  if (e != hipSuccess) fprintf(stderr, "cooperative launch failed: %s (grid %d)\n", hipGetErrorString(e), grid_blocks);
}
```
